# Optimizing an MI355X kernel written in HIP

```python
import math
import jax, jax.numpy as jnp
from jax import lax
import numpy as np

D_MODEL = 2048
BATCH = 4
SEQ = 2048
DEPTH = 1
DEC_BATCH = 8
DEC_SEQ = 32
PAST_LEN = 1024

CHUNK = 64
HEAD_DIM = 64
ATT_HEADS = D_MODEL // 2 // HEAD_DIM
ATT_KV_HEADS = 2
ATT_GROUP = ATT_HEADS // ATT_KV_HEADS
ATT_WIDTH = ATT_HEADS * HEAD_DIM
KV_WIDTH = ATT_KV_HEADS * HEAD_DIM
WINDOW = 128
WINDOW_CHUNKS = WINDOW // CHUNK
ROPE_THETA = 10000.0
ATT_SCALE = HEAD_DIM ** -0.5
RW_HEADS = D_MODEL // 2 // HEAD_DIM
RW_WIDTH = RW_HEADS * HEAD_DIM
DECAY_LORA = 64
AAA_LORA = 64
GATE_LORA = 160
LNX_EPS = 64e-5
ATT_SIZES = (ATT_WIDTH, KV_WIDTH, KV_WIDTH)
RW_SIZES = (RW_WIDTH, DECAY_LORA, RW_WIDTH, RW_WIDTH, AAA_LORA, GATE_LORA)
ATT_COLS = ATT_WIDTH + 2 * KV_WIDTH
RW_COLS = 3 * RW_WIDTH + DECAY_LORA + AAA_LORA + GATE_LORA
IN_COLS = ATT_COLS + RW_COLS
MIX_WIDTH = ATT_WIDTH + RW_WIDTH
D_FF = 5632
CONV_W = 3
LN_EPS = 1e-5
ALPHA = (2 * DEPTH) ** 0.25
BETA = (8 * DEPTH) ** -0.25

kernel_name = 'hybrid_swa_sink_rwkv7_convffn_stream_step'


def layer_norm(x, g, b, eps=LN_EPS):
    xf = x.astype(jnp.float32)
    mu = jnp.mean(xf, -1, keepdims=True)
    var = jnp.mean(jnp.square(xf - mu), -1, keepdims=True)
    return ((xf - mu) * lax.rsqrt(var + eps) * g + b).astype(x.dtype)


def split_cols(p, sizes):
    out, start = [], 0
    for s in sizes:
        out.append(p[..., start:start + s])
        start += s
    return out


def rope(x, pos):
    half = HEAD_DIM // 2
    inv = ROPE_THETA ** (-jnp.arange(half, dtype=jnp.float32) / half)
    ang = pos.astype(jnp.float32)[:, None] * inv[None, :]
    cos = jnp.cos(ang)[None, :, None, :]
    sin = jnp.sin(ang)[None, :, None, :]
    xf = x.astype(jnp.float32)
    x1, x2 = xf[..., :half], xf[..., half:]
    return jnp.concatenate([x1 * cos - x2 * sin, x2 * cos + x1 * sin], -1).astype(x.dtype)


def sink_softmax(s, sink):
    m = jnp.maximum(jnp.max(s, -1), sink)
    p = jnp.exp(s - m[..., None])
    den = jnp.sum(p, -1) + jnp.exp(sink - m)
    return p / den[..., None]


def band_attention_prompt(q, k, v, sinks):
    B, T = q.shape[0], q.shape[1]
    nc = T // CHUNK
    qc = q.reshape(B, nc, CHUNK, ATT_KV_HEADS, ATT_GROUP, HEAD_DIM)

    def band(t):
        tc = t.reshape(B, nc, CHUNK, ATT_KV_HEADS, HEAD_DIM)
        tp = jnp.pad(tc, ((0, 0), (WINDOW_CHUNKS, 0), (0, 0), (0, 0), (0, 0)))
        return jnp.concatenate([tp[:, i:i + nc] for i in range(WINDOW_CHUNKS + 1)], axis=2)

    kb, vb = band(k), band(v)
    slot_chunk = jnp.repeat(jnp.arange(WINDOW_CHUNKS + 1), CHUNK)
    valid = (jnp.arange(nc)[:, None] - WINDOW_CHUNKS + slot_chunk[None, :]) >= 0
    s = jnp.einsum('bnqkgd,bnskd->bnkgqs', qc, kb, preferred_element_type=jnp.float32) * ATT_SCALE
    s = jnp.where(valid[None, :, None, None, None, :], s, -jnp.inf)
    p = sink_softmax(s, sinks.astype(jnp.float32).reshape(ATT_KV_HEADS, ATT_GROUP, 1))
    o = jnp.einsum('bnkgqs,bnskd->bnqkgd', p.astype(v.dtype), vb)
    return o.reshape(B, T, ATT_WIDTH)


def window_attention_step(q, k_new, v_new, k_buf, v_buf, sinks):
    B, T = q.shape[0], q.shape[1]
    k_all = jnp.concatenate([k_buf, k_new], axis=1)
    v_all = jnp.concatenate([v_buf, v_new], axis=1)
    qg = q.reshape(B, T, ATT_KV_HEADS, ATT_GROUP, HEAD_DIM)
    s = jnp.einsum('bqkgd,bskd->bkgqs', qg, k_all, preferred_element_type=jnp.float32) * ATT_SCALE
    p = sink_softmax(s, sinks.astype(jnp.float32).reshape(ATT_KV_HEADS, ATT_GROUP, 1))
    o = jnp.einsum('bkgqs,bskd->bqkgd', p.astype(v_all.dtype), v_all)
    return o.reshape(B, T, ATT_WIDTH), k_all[:, -WINDOW:], v_all[:, -WINDOW:]


def wkv7_scan(r, decay, k, v, a, b, s0):
    def step(S, inp):
        r_t, w_t, k_t, v_t, a_t, b_t = inp
        sa = jnp.einsum('bhij,bhj->bhi', S, a_t)
        S = S * w_t[:, :, None, :] + sa[..., None] * b_t[:, :, None, :] + v_t[..., None] * k_t[:, :, None, :]
        return S, jnp.einsum('bhij,bhj->bhi', S, r_t)

    xs = tuple(jnp.moveaxis(t, 1, 0) for t in (r, decay, k, v, a, b))
    s_last, out = lax.scan(step, s0, xs)
    return jnp.moveaxis(out, 0, 1), s_last


def token_mixer(x, pos, shift_prev, wkv0, k_buf, v_buf, lp):
    B, T = x.shape[0], x.shape[1]
    p = x @ lp['w_in']
    p_att, p_rw = p[..., :ATT_COLS], p[..., ATT_COLS:]
    q, k, v = split_cols(p_att, ATT_SIZES)
    q = rope(q.reshape(B, T, ATT_HEADS, HEAD_DIM), pos)
    k = rope(k.reshape(B, T, ATT_KV_HEADS, HEAD_DIM), pos)
    v = v.reshape(B, T, ATT_KV_HEADS, HEAD_DIM)
    if k_buf is None:
        att = band_attention_prompt(q, k, v, lp['sinks'])
        k_win, v_win = k[:, -WINDOW:], v[:, -WINDOW:]
    else:
        att, k_win, v_win = window_attention_step(q, k, v, k_buf, v_buf, lp['sinks'])
    prev = jnp.concatenate([shift_prev, p_rw[:, :-1]], axis=1)
    xs = p_rw + (prev - p_rw) * lp['mu']
    r, wd, kr, vr, ad, gd = split_cols(xs, RW_SIZES)
    w_log = -jax.nn.softplus(-(lp['w0'] + jnp.tanh(wd) @ lp['w2'])) - 0.5
    decay = jnp.exp(-jnp.exp(w_log.astype(jnp.float32)))
    a = jax.nn.sigmoid(lp['a0'] + ad @ lp['a2'])
    g = jax.nn.sigmoid(gd) @ lp['g2']

    def heads(t):
        return t.reshape(B, T, RW_HEADS, HEAD_DIM).astype(jnp.float32)

    kk = heads(kr * lp['k_k'])
    kk = kk / jnp.maximum(jnp.sqrt(jnp.sum(kk * kk, -1, keepdims=True)), 1e-12)
    kr = kr * (1.0 + (a - 1.0) * lp['k_a'])
    rh, kh, vh, ah = heads(r), heads(kr), heads(vr), heads(a)
    o, wkv_last = wkv7_scan(rh, heads(decay), kh, vh, -kk, kk * ah, wkv0.astype(jnp.float32))
    mo = jnp.mean(o, -1, keepdims=True)
    vo = jnp.mean(jnp.square(o - mo), -1, keepdims=True)
    on = ((o - mo) * lax.rsqrt(vo + LNX_EPS)).reshape(B, T, RW_WIDTH) * lp['lnx_g'] + lp['lnx_b']
    bonus = jnp.sum(rh * kh * lp['r_k'].astype(jnp.float32), -1, keepdims=True) * vh
    rw_out = ((on + bonus.reshape(B, T, RW_WIDTH)) * g).astype(x.dtype)
    mixed = jnp.concatenate([att.astype(x.dtype), rw_out], axis=-1) @ lp['w_out']
    return mixed, k_win, v_win, wkv_last.astype(wkv0.dtype), p_rw[:, -1:]


def conv_ffn(x, conv_prev, lp):
    T = x.shape[1]
    up = x @ lp['w_up']
    ext = jnp.concatenate([conv_prev, up], axis=1)
    c = lp['conv_b']
    for i in range(CONV_W):
        c = c + ext[:, i:i + T] * lp['conv_w'][i]
    gate, val = c[..., :D_FF], c[..., D_FF:]
    y = (jax.nn.gelu(gate, approximate=False) * val) @ lp['w_down']
    return y, ext[:, -(CONV_W - 1):]


def setup_inputs(seed: int = 0) -> dict:
    key = jax.random.key(seed)
    ks = jax.random.split(key, 32)
    f32 = jnp.float32
    nrm = lambda k, shape, s=1.0: (jax.random.normal(k, shape, f32) * s)
    return {
        'x_prompt': nrm(ks[0], (BATCH, SEQ, D_MODEL)),
        'x_sample': nrm(ks[1], (DEC_BATCH, DEC_SEQ, D_MODEL)),
        'cache_k': nrm(ks[2], (DEPTH, DEC_BATCH, WINDOW, ATT_KV_HEADS, HEAD_DIM)),
        'cache_v': nrm(ks[3], (DEPTH, DEC_BATCH, WINDOW, ATT_KV_HEADS, HEAD_DIM)),
        'state_wkv': nrm(ks[4], (DEPTH, DEC_BATCH, RW_HEADS, HEAD_DIM, HEAD_DIM), 0.5),
        'state_shift': nrm(ks[5], (DEPTH, DEC_BATCH, 1, RW_COLS)),
        'state_ffn_conv': nrm(ks[6], (DEPTH, DEC_BATCH, CONV_W - 1, 2 * D_FF)),
        'ln_in_g': 1.0 + nrm(ks[7], (D_MODEL,), 0.02),
        'ln_in_b': nrm(ks[8], (D_MODEL,), 0.02),
        'w_in': nrm(ks[9], (DEPTH, D_MODEL, IN_COLS), D_MODEL ** -0.5),
        'attn_sinks': nrm(ks[10], (DEPTH, ATT_HEADS)),
        'rw_mu': jax.random.uniform(ks[11], (DEPTH, RW_COLS), f32),
        'rw_w0': jax.random.uniform(ks[12], (DEPTH, RW_WIDTH), f32, -6.0, -1.0),
        'rw_w2': nrm(ks[13], (DEPTH, DECAY_LORA, RW_WIDTH), 0.1 * DECAY_LORA ** -0.5),
        'rw_a0': nrm(ks[14], (DEPTH, RW_WIDTH), 0.1),
        'rw_a2': nrm(ks[15], (DEPTH, AAA_LORA, RW_WIDTH), 0.1 * AAA_LORA ** -0.5),
        'rw_g2': nrm(ks[16], (DEPTH, GATE_LORA, RW_WIDTH), GATE_LORA ** -0.5),
        'rw_k_k': 0.85 + nrm(ks[17], (DEPTH, RW_WIDTH), 0.02),
        'rw_k_a': 1.0 + nrm(ks[18], (DEPTH, RW_WIDTH), 0.02),
        'rw_r_k': nrm(ks[19], (DEPTH, RW_HEADS, HEAD_DIM), 0.1),
        'rw_lnx_g': 1.0 + nrm(ks[20], (DEPTH, RW_WIDTH), 0.02),
        'rw_lnx_b': nrm(ks[21], (DEPTH, RW_WIDTH), 0.02),
        'w_out': nrm(ks[22], (DEPTH, MIX_WIDTH, D_MODEL), BETA * MIX_WIDTH ** -0.5),
        'ln1_g': 1.0 + nrm(ks[23], (DEPTH, D_MODEL), 0.02),
        'ln1_b': nrm(ks[24], (DEPTH, D_MODEL), 0.02),
        'ffn_w_up': nrm(ks[25], (DEPTH, D_MODEL, 2 * D_FF), D_MODEL ** -0.5),
        'ffn_conv_w': nrm(ks[26], (DEPTH, CONV_W, 2 * D_FF), CONV_W ** -0.5),
        'ffn_conv_b': nrm(ks[27], (DEPTH, 2 * D_FF), 0.02),
        'ffn_w_down': nrm(ks[28], (DEPTH, D_FF, D_MODEL), BETA * D_FF ** -0.5),
        'ln2_g': 1.0 + nrm(ks[29], (DEPTH, D_MODEL), 0.02),
        'ln2_b': nrm(ks[30], (DEPTH, D_MODEL), 0.02),
    }


def reference(x_prompt, x_sample, cache_k, cache_v, state_wkv, state_shift, state_ffn_conv,
              ln_in_g, ln_in_b, w_in, attn_sinks, rw_mu, rw_w0, rw_w2, rw_a0, rw_a2, rw_g2,
              rw_k_k, rw_k_a, rw_r_k, rw_lnx_g, rw_lnx_b, w_out, ln1_g, ln1_b,
              ffn_w_up, ffn_conv_w, ffn_conv_b, ffn_w_down, ln2_g, ln2_b):
    def layer_params(l):
        return {'w_in': w_in[l], 'sinks': attn_sinks[l], 'mu': rw_mu[l], 'w0': rw_w0[l], 'w2': rw_w2[l],
                'a0': rw_a0[l], 'a2': rw_a2[l], 'g2': rw_g2[l], 'k_k': rw_k_k[l], 'k_a': rw_k_a[l],
                'r_k': rw_r_k[l], 'lnx_g': rw_lnx_g[l], 'lnx_b': rw_lnx_b[l], 'w_out': w_out[l],
                'w_up': ffn_w_up[l], 'conv_w': ffn_conv_w[l], 'conv_b': ffn_conv_b[l], 'w_down': ffn_w_down[l]}

    def run(x, pos, layer_states):
        h = layer_norm(x, ln_in_g, ln_in_b)
        ks_, vs_, ws_, ss_, cs_ = [], [], [], [], []
        for l in range(DEPTH):
            ck, cv, cw, csh, cf = layer_states[l]
            lp = layer_params(l)
            m, kb, vb, wkv, sh = token_mixer(h, pos, csh, cw, ck, cv, lp)
            h = layer_norm(ALPHA * h + m, ln1_g[l], ln1_b[l])
            f, cb = conv_ffn(h, cf, lp)
            h = layer_norm(ALPHA * h + f, ln2_g[l], ln2_b[l])
            ks_.append(kb); vs_.append(vb); ws_.append(wkv); ss_.append(sh); cs_.append(cb)
        return h, jnp.stack(ks_), jnp.stack(vs_), jnp.stack(ws_), jnp.stack(ss_), jnp.stack(cs_)

    bp, tp = x_prompt.shape[0], x_prompt.shape[1]
    prompt_states = [(None, None,
                      jnp.zeros((bp, RW_HEADS, HEAD_DIM, HEAD_DIM), jnp.float32),
                      jnp.zeros((bp, 1, RW_COLS), x_prompt.dtype),
                      jnp.zeros((bp, CONV_W - 1, 2 * D_FF), x_prompt.dtype)) for _ in range(DEPTH)]
    y_prompt, p_k, p_v, p_wkv, p_shift, p_conv = run(x_prompt, jnp.arange(tp, dtype=jnp.int32), prompt_states)

    ts = x_sample.shape[1]
    sample_states = [(cache_k[l], cache_v[l], state_wkv[l], state_shift[l], state_ffn_conv[l]) for l in range(DEPTH)]
    y_sample, s_k, s_v, s_wkv, s_shift, s_conv = run(
        x_sample, PAST_LEN + jnp.arange(ts, dtype=jnp.int32), sample_states)
    return (y_prompt, y_sample, p_k, p_v, p_wkv, p_shift, p_conv, s_k, s_v, s_wkv, s_shift, s_conv)
```

```cpp
#include <hip/hip_runtime.h>
#include <cstdio>
#include <cstdint>

#ifndef DUP_K
#define DUP_K -1
#endif
#ifndef DUP_MASK
#define DUP_MASK 0u
#endif
#define REP(k) for (int rep_ = 0; rep_ < ((DUP_K == (k) || ((DUP_MASK >> (k)) & 1u)) ? 2 : 1); ++rep_)
#ifndef MK_PER_PHASE
#define MK_PER_PHASE 0
#endif

namespace pg8 {
#define PG8_LAS __attribute__((address_space(3)))
typedef unsigned short bf16_t;
typedef short bf16x8 __attribute__((ext_vector_type(8)));
typedef float f32x4 __attribute__((ext_vector_type(4)));
typedef unsigned u32x4 __attribute__((ext_vector_type(4)));
constexpr int BM = 256, BK = 64, HALF = 128, HTB = HALF * BK * 2, STAGE_BYTES = 8 * HTB, NXCD = 8, WGM = 8;

__host__ __device__ __forceinline__ int lds_byte(int r, int c) { const int st = (r >> 4) * 2 + (c >> 5), rr = r & 15, cc = c & 31, ob = rr * 64 + cc * 2; return st * 1024 + (ob ^ (((ob >> 9) & 1) << 5)); }
__host__ __device__ __forceinline__ void stage_rc(int b, int& R, int& C) { const int st = b / 1024, sb = b % 1024, swz = sb ^ (((sb >> 9) & 1) << 5); R = (st >> 1) * 16 + swz / 64; C = (st & 1) * 32 + (swz % 64) / 2; }
__host__ __device__ __forceinline__ int perm32(int rho) { const int n = rho >> 4, i = rho & 15; return 8 * (i >> 2) + 4 * n + (i & 3); }

struct Unit { int pm, pn, kt0, nt, ks; };
struct Gemm { const bf16_t* A; const bf16_t* Bt; int M, N, K, lda, ldb; };

struct StaticOrder {
    int nM, nN, nwg, G, c, ntf;
    __host__ __device__ void init(int M, int N, int G_, int c_, int K_ = 2048) { nM = M / BM; nN = N / BM; nwg = nM * nN; G = G_; c = c_; ntf = K_ / BK; }
    __host__ __device__ bool next(int i, Unit& u) const {
        u.kt0 = 0; u.nt = ntf; u.ks = 0;
        const long L = (long)i * G + c; if (L >= nwg) return false;
        int wgid = (int)L; { const int q = nwg / NXCD, r = nwg % NXCD, xcd = wgid % NXCD, off = wgid / NXCD; wgid = (xcd < r ? xcd * (q + 1) : r * (q + 1) + (xcd - r) * q) + off; }
        const int nig = WGM * nN, gid = wgid / nig, fm = gid * WGM, gsz = (nM - fm) < WGM ? (nM - fm) : WGM;
        u.pm = fm + ((wgid % nig) % gsz); u.pn = (wgid % nig) / gsz; return true;
    }
};

struct SubOrder {
    int pm, nN, S, ntp, G, c;
    __host__ __device__ void init(int pm_, int N, int K, int S_, int G_, int c_) { pm = pm_; nN = N / BM; S = S_; ntp = K / BK / S_; G = G_; c = c_; }
    __host__ __device__ bool next(int i, Unit& u) const {
        const long j = (long)i * G + c; if (j >= nN * S) return false;
        u.pm = pm; u.pn = (int)j % nN; u.ks = (int)j / nN; u.kt0 = u.ks * ntp; u.nt = ntp; return true;
    }
};
__device__ __forceinline__ unsigned cvt_pk_bf16(float lo, float hi) { unsigned r; asm volatile("v_cvt_pk_bf16_f32 %0, %1, %2" : "=v"(r) : "v"(lo), "v"(hi)); return r; }
typedef float f32x2 __attribute__((ext_vector_type(2)));
__device__ __forceinline__ f32x2 gelu_pk(f32x2 v) {
    const f32x2 av = __builtin_elementwise_abs(v), d = av * 0.2316418882f + 1.0f;
    f32x2 t; t.x = __builtin_amdgcn_rcpf(d.x); t.y = __builtin_amdgcn_rcpf(d.y);
    f32x2 q = t * 0.5307027145f + (-0.7265760135f); q = q * t + 0.7107068705f; q = q * t + (-0.142248368f); q = q * t + 0.127414796f; q = q * t;
    const f32x2 s = (v * v) * (-0.72134752044f);
    f32x2 e; e.x = __builtin_amdgcn_exp2f(s.x); e.y = __builtin_amdgcn_exp2f(s.y);
    const f32x2 m = v * (q * e), r = v - m;
    f32x2 o; o.x = v.x < 0.f ? m.x : r.x; o.y = v.y < 0.f ? m.y : r.y; return o;
}

template <class Epi, class Sched, bool ALIGN_EPI = false, bool SP2 = false>
__device__ __forceinline__ void gemm_phase(PG8_LAS unsigned char* lds, const Gemm g, const Sched& S, const Epi& E) {
    int tid_ = threadIdx.x; asm volatile("" : "+v"(tid_));
    const int tid = tid_, wid = __builtin_amdgcn_readfirstlane(tid >> 6), lane = tid & 63, wr = wid >> 2, wc = wid & 3, fr = lane & 15, fq = lane >> 4;
    unsigned voffA[2], voffB[2];
#pragma unroll
    for (int i = 0; i < 2; ++i) { int R, C; stage_rc(tid * 16 + i * 8192, R, C); const int Rb = Epi::PERM ? ((R & ~31) + perm32(R & 31)) : R;
        voffA[i] = (unsigned)(R * g.lda + C) * 2u; voffB[i] = (unsigned)(Rb * g.ldb + C) * 2u; }
    const size_t kstep = (size_t)(BK * 2);
    const size_t hstepA = (size_t)HALF * g.lda * 2, hstepB = (size_t)HALF * g.ldb * 2;
    const size_t tstepA = 2 * hstepA, tstepB = 2 * hstepB;
    const unsigned ldsw = (unsigned)wid * 1024u;
    const int aoff = lds_byte(wr * 64 + fr, fq * 8), boff = lds_byte(wc * 32 + fr, fq * 8);
#define PG8_SA(b, h) (((b) * 2 + (h)) * HTB)
#define PG8_SB(b, h) ((4 + (b) * 2 + (h)) * HTB)
#define PG8_STAGE(bufoff, gbase, voff) do { _Pragma("unroll") for (int _i = 0; _i < 2; ++_i) \
        __builtin_amdgcn_global_load_lds((const unsigned*)((const char*)(gbase) + (voff)[_i]), (PG8_LAS unsigned*)(lds + (bufoff) + ldsw + _i * 8192), 16, 0, 0); } while (0)
#define PG8_LDA(dst, b, h) do { _Pragma("unroll") for (int m = 0; m < 4; ++m) _Pragma("unroll") for (int k = 0; k < 2; ++k) dst[m][k] = *(const PG8_LAS bf16x8*)(lds + PG8_SA(b, h) + aoff + m * 2048 + k * 1024); } while (0)
#define PG8_LDB(dst, b, h) do { _Pragma("unroll") for (int n = 0; n < 2; ++n) _Pragma("unroll") for (int k = 0; k < 2; ++k) dst[n][k] = *(const PG8_LAS bf16x8*)(lds + PG8_SB(b, h) + boff + n * 2048 + k * 1024); } while (0)
#define PG8_MMA(ai, bj, At, Bt) do { __builtin_amdgcn_s_setprio(1); _Pragma("unroll") for (int m = 0; m < 4; ++m) _Pragma("unroll") for (int n = 0; n < 2; ++n) _Pragma("unroll") for (int k = 0; k < 2; ++k) \
        acc[ai][bj][m][n] = __builtin_amdgcn_mfma_f32_16x16x32_bf16(Bt[n][k], At[m][k], acc[ai][bj][m][n], 0, 0, 0); __builtin_amdgcn_s_setprio(0); } while (0)
#define PG8_WAIT_V(n) asm volatile("s_waitcnt vmcnt(" #n ")" ::: "memory")
#define PG8_WAIT_L(n) asm volatile("s_waitcnt lgkmcnt(" #n ")" ::: "memory")
#define PG8_BAR __builtin_amdgcn_s_barrier()
#define PG8_SCHED __builtin_amdgcn_sched_barrier(0)
    Unit cur, nxt; int ui = 0;
    if (!S.next(0, cur)) return;
    f32x4 acc[2][2][4][2];
#pragma unroll
    for (int a = 0; a < 2; ++a)
#pragma unroll
        for (int b = 0; b < 2; ++b)
#pragma unroll
            for (int m = 0; m < 4; ++m)
#pragma unroll
                for (int n = 0; n < 2; ++n) acc[a][b][m][n] = (f32x4){0.f, 0.f, 0.f, 0.f};
    bf16x8 At[4][2], B0[2][2], B1[2][2];
    int nt = cur.nt;
    const char* cA = (const char*)g.A + (size_t)cur.pm * tstepA + (size_t)cur.kt0 * kstep; const char* cB = (const char*)g.Bt + (size_t)cur.pn * tstepB + (size_t)cur.kt0 * kstep;
    if constexpr (SP2) {
        PG8_STAGE(PG8_SB(0, 0), cB, voffB); PG8_STAGE(PG8_SB(0, 1), cB + hstepB, voffB); PG8_STAGE(PG8_SA(0, 0), cA, voffA); PG8_STAGE(PG8_SA(0, 1), cA + hstepA, voffA);
        if (wr == 1) PG8_BAR;
        PG8_WAIT_V(2); PG8_BAR;
        PG8_STAGE(PG8_SB(1, 0), cB + kstep, voffB); PG8_STAGE(PG8_SA(1, 0), cA + kstep, voffA); PG8_STAGE(PG8_SB(1, 1), cB + hstepB + kstep, voffB);
        PG8_WAIT_V(6); PG8_BAR;
    } else {
        PG8_STAGE(PG8_SB(0, 0), cB, voffB); PG8_STAGE(PG8_SA(0, 0), cA, voffA); PG8_STAGE(PG8_SB(0, 1), cB + hstepB, voffB); PG8_STAGE(PG8_SA(0, 1), cA + hstepA, voffA);
        if (wr == 1) PG8_BAR;
        PG8_WAIT_V(4); PG8_BAR;
        PG8_STAGE(PG8_SB(1, 0), cB + kstep, voffB); PG8_STAGE(PG8_SA(1, 0), cA + kstep, voffA); PG8_STAGE(PG8_SB(1, 1), cB + hstepB + kstep, voffB);
        PG8_WAIT_V(6); PG8_BAR;
    }
    for (;;) {
        const bool has_next = S.next(ui + 1, nxt);
        const char* nA = has_next ? (const char*)g.A + (size_t)nxt.pm * tstepA + (size_t)nxt.kt0 * kstep : cA; const char* nB = has_next ? (const char*)g.Bt + (size_t)nxt.pn * tstepB + (size_t)nxt.kt0 * kstep : cB;
        for (int t = 0; t < nt; t += 2) {
            const bool last = (t == nt - 2);
            const char* a1 = cA + (size_t)(t + 1) * kstep;
            const char* a2 = last ? nA : cA + (size_t)(t + 2) * kstep; const char* b2 = last ? nB : cB + (size_t)(t + 2) * kstep;
            const char* a3 = a2 + kstep; const char* b3 = b2 + kstep;
            if constexpr (SP2) {
            PG8_LDB(B0, 0, 0); PG8_LDB(B1, 0, 1); PG8_SCHED; PG8_LDA(At, 0, 0); PG8_STAGE(PG8_SA(1, 1), a1 + hstepA, voffA);
            PG8_WAIT_V(8); PG8_WAIT_L(0); PG8_BAR; PG8_MMA(0, 0, At, B0); PG8_MMA(0, 1, At, B1); PG8_BAR; PG8_SCHED;
            PG8_LDA(At, 0, 1); PG8_STAGE(PG8_SB(0, 0), b2, voffB); PG8_STAGE(PG8_SB(0, 1), b2 + hstepB, voffB); PG8_STAGE(PG8_SA(0, 0), a2, voffA);
            PG8_WAIT_V(8); PG8_WAIT_L(0); PG8_BAR; PG8_MMA(1, 0, At, B0); PG8_MMA(1, 1, At, B1); PG8_BAR; PG8_SCHED;
            PG8_LDB(B0, 1, 0); PG8_LDB(B1, 1, 1); PG8_SCHED; PG8_LDA(At, 1, 0); PG8_STAGE(PG8_SA(0, 1), a2 + hstepA, voffA);
            PG8_WAIT_V(8); PG8_WAIT_L(0); PG8_BAR; PG8_MMA(0, 0, At, B0); PG8_MMA(0, 1, At, B1); PG8_BAR; PG8_SCHED;
            PG8_LDA(At, 1, 1); PG8_STAGE(PG8_SB(1, 0), b3, voffB); PG8_STAGE(PG8_SB(1, 1), b3 + hstepB, voffB); PG8_STAGE(PG8_SA(1, 0), a3, voffA);
            PG8_WAIT_V(8); PG8_WAIT_L(0); PG8_BAR; PG8_MMA(1, 0, At, B0); PG8_MMA(1, 1, At, B1); PG8_BAR; PG8_SCHED;
            } else {
            PG8_LDB(B0, 0, 0); PG8_SCHED; PG8_LDA(At, 0, 0); PG8_STAGE(PG8_SA(1, 1), a1 + hstepA, voffA);
            PG8_WAIT_L(8); PG8_BAR; PG8_WAIT_L(0); PG8_MMA(0, 0, At, B0); PG8_BAR; PG8_SCHED;
            PG8_LDB(B1, 0, 1); PG8_STAGE(PG8_SB(0, 0), b2, voffB);
            PG8_BAR; PG8_WAIT_L(0); PG8_MMA(0, 1, At, B1); PG8_BAR;
            PG8_LDA(At, 0, 1); PG8_STAGE(PG8_SA(0, 0), a2, voffA);
            PG8_BAR; PG8_WAIT_L(0); PG8_MMA(1, 0, At, B0); PG8_BAR; PG8_SCHED;
            PG8_STAGE(PG8_SB(0, 1), b2 + hstepB, voffB);
            PG8_WAIT_V(6); PG8_BAR; PG8_MMA(1, 1, At, B1); PG8_BAR;
            PG8_LDB(B0, 1, 0); PG8_SCHED; PG8_LDA(At, 1, 0); PG8_STAGE(PG8_SA(0, 1), a2 + hstepA, voffA);
            PG8_WAIT_L(8); PG8_BAR; PG8_WAIT_L(0); PG8_MMA(0, 0, At, B0); PG8_BAR; PG8_SCHED;
            PG8_LDB(B1, 1, 1); PG8_STAGE(PG8_SB(1, 0), b3, voffB);
            PG8_BAR; PG8_WAIT_L(0); PG8_MMA(0, 1, At, B1); PG8_BAR;
            PG8_LDA(At, 1, 1); PG8_STAGE(PG8_SA(1, 0), a3, voffA);
            PG8_BAR; PG8_WAIT_L(0); PG8_MMA(1, 0, At, B0); PG8_BAR; PG8_SCHED;
            PG8_STAGE(PG8_SB(1, 1), b3 + hstepB, voffB);
            PG8_WAIT_V(6); PG8_BAR; PG8_MMA(1, 1, At, B1); PG8_BAR;
            }
        }
        if constexpr (ALIGN_EPI) { if (wr == 0) PG8_BAR; }
        E(acc, cur, wr, wc, fr, fq);
        if (!has_next) break;
#pragma unroll
        for (int a = 0; a < 2; ++a)
#pragma unroll
            for (int b = 0; b < 2; ++b)
#pragma unroll
                for (int m = 0; m < 4; ++m)
#pragma unroll
                    for (int n = 0; n < 2; ++n) acc[a][b][m][n] = (f32x4){0.f, 0.f, 0.f, 0.f};
        cur = nxt; cA = nA; cB = nB; nt = cur.nt; ++ui;
        if constexpr (ALIGN_EPI) { if (wr == 1) PG8_BAR; }
    }
    PG8_WAIT_V(0);
    if constexpr (!ALIGN_EPI) { if (wr == 0) PG8_BAR; }
    PG8_BAR;
#undef PG8_SA
#undef PG8_SB
#undef PG8_STAGE
#undef PG8_LDA
#undef PG8_LDB
#undef PG8_MMA
#undef PG8_WAIT_V
#undef PG8_WAIT_L
#undef PG8_BAR
#undef PG8_SCHED
}
}

constexpr int NWAVES = 8;
constexpr int DM = 2048, NTOK = 8448, NPROMPT = 8192;
constexpr int INC = 4640, N1 = 4864, RWC = 3360, PRW_LD = 3584, DFF = 5632, NUP = 11264;
constexpr float LN_EPS = 1e-5f, LNX_EPS = 64e-5f;
constexpr float ALPHA = 1.189207115002721f;
constexpr int RC_R = 0, RC_WD = 1024, RC_K = 1088, RC_V = 2112, RC_AD = 3136, RC_GD = 3200;
constexpr size_t O_Y = 0, O_PK = 17301504, O_PV = 17367040, O_PWKV = 17432576, O_PSHIFT = 17694720, O_PCONV = 17708160,
                 O_SK = 17798272, O_SV = 17929344, O_SWKV = 18060416, O_SSHIFT = 18584704, O_SCONV = 18611584;
constexpr size_t MiB = 1u << 20;
constexpr size_t QMiB = 1u << 18;
constexpr size_t WS_CTL = 0, CTL_ZERO_BYTES = 1 * MiB;
constexpr size_t WS_BT1 = 1 * MiB;
constexpr size_t WS_BT4 = 1 * MiB;
constexpr size_t WS_H0B = 23 * MiB;
constexpr size_t WS_REC = 23 * MiB;
constexpr size_t WS_G   = 188 * MiB;
constexpr size_t WS_SLAB = 23 * MiB;
constexpr size_t WS_UP  = 23 * MiB;
constexpr size_t WS_PRW = 818 * QMiB;
constexpr size_t WS_BT3 = 818 * QMiB;
constexpr size_t WS_O   = 994 * QMiB;
constexpr size_t WS_H1B = 994 * QMiB;
constexpr size_t WS_ALORA = 1049 * QMiB;
constexpr size_t WS_ASIG = 1082 * QMiB;
constexpr size_t WS_VCOPY = 287 * MiB;
constexpr size_t WS_ACT = 818 * QMiB;
constexpr size_t WS_BT2 = 1218 * QMiB;
constexpr size_t WS_MIX = 1250 * QMiB;
constexpr size_t WS_KB  = 1382 * QMiB;
constexpr size_t KB_SAMP = (size_t)NPROMPT * 128;
constexpr size_t WS_VT  = WS_KB + (KB_SAMP + 8 * 160 * 128) * 2;
constexpr size_t VT_SAMP = (size_t)4 * 128 * 2048;
constexpr size_t WS_ROPE = WS_VT + (VT_SAMP + 8 * 128 * 160) * 2;
constexpr size_t WS_RKR = WS_ROPE + 2048 * 64 * 4;
constexpr size_t WS_END = WS_RKR + (size_t)NTOK * 16 * 4;
constexpr size_t WS_BTD = 1214 * QMiB;
constexpr size_t WS_BTA = WS_BTD + 1024 * 128 * 2;
constexpr size_t WS_BTG = WS_BTA + 1024 * 128 * 2;
static_assert(WS_BTG + 1024 * 256 * 2 <= 1218 * QMiB, "lora weights below bt2");
static_assert(WS_END <= 352 * MiB, "ws map");
static_assert(WS_ALORA >= WS_PRW + (size_t)NTOK * PRW_LD * 2, "alora after prw");
static_assert(WS_ACT + (size_t)NTOK * DFF * 2 <= WS_BT2, "act below bt2");
static_assert(WS_VCOPY + (size_t)NTOK * 1024 * 2 <= WS_BTD, "vcopy below lora weights");
static_assert(WS_REC + (size_t)NTOK * 16 * 320 * 4 <= WS_G, "rec below g");
static_assert(WS_UP + (size_t)NTOK * NUP * 2 <= WS_BT3, "up below bt3");
constexpr int CW_BAR = 4096;

constexpr int RING_BYTES = 131072;
constexpr int LDSCTL_OFF = RING_BYTES, MISC_OFF = LDSCTL_OFF + 320;
constexpr int LDS_BYTES = 147456;

#define GAS __attribute__((address_space(1)))
#define LAS __attribute__((address_space(3)))
typedef unsigned short bf16;
typedef unsigned v4u __attribute__((ext_vector_type(4)));
typedef unsigned v2u __attribute__((ext_vector_type(2)));
typedef float f32x4 __attribute__((ext_vector_type(4)));
typedef float f32x2 __attribute__((ext_vector_type(2)));
typedef float f32x16 __attribute__((ext_vector_type(16)));
typedef short bf16x8 __attribute__((ext_vector_type(8)));
typedef short s16x4 __attribute__((ext_vector_type(4)));
typedef GAS unsigned gu32;
#define RLX_AGENT __ATOMIC_RELAXED, __HIP_MEMORY_SCOPE_AGENT
#define LDS_WAIT() asm volatile("s_waitcnt lgkmcnt(0)" ::: "memory")
#define VM_WAIT() asm volatile("s_waitcnt vmcnt(0)" ::: "memory")
__device__ __forceinline__ unsigned f2bf(float f) { unsigned u = __builtin_bit_cast(unsigned, f); return (u + 0x7fffu + ((u >> 16) & 1u)) >> 16; }
__device__ __forceinline__ unsigned pk2(float lo, float hi) { return f2bf(lo) | (f2bf(hi) << 16); }
__device__ __forceinline__ float bf_lo(unsigned w) { return __builtin_bit_cast(float, w << 16); }
__device__ __forceinline__ float bf_hi(unsigned w) { return __builtin_bit_cast(float, w & 0xffff0000u); }

#define XB_TMO      128
#define XB_XCNT(j)  (256  + 64 * (j))
#define XB_XSUB(j)  (1280 + 64 * (j))
#define XB_XGEN(j)  (2304 + 64 * (j))
#define XB_TOP      3328
#define XB_TOPGEN   3392
#define XCD_BAR_WORDS 3456
#define XB_SPIN_CAP (1u << 18)
__device__ __forceinline__ unsigned xb_ld(unsigned* p)              { return __hip_atomic_load(p, __ATOMIC_RELAXED, __HIP_MEMORY_SCOPE_AGENT); }
__device__ __forceinline__ unsigned xb_add(unsigned* p, unsigned v) { return __hip_atomic_fetch_add(p, v, __ATOMIC_RELAXED, __HIP_MEMORY_SCOPE_AGENT); }
__device__ __forceinline__ unsigned xb_xcc_id() { return (unsigned)__builtin_amdgcn_s_getreg((3 << 11) | 20) & 0xFu; }
#define XB_SPIN(cond, bar) do { unsigned _sp = 0; while (cond) { __builtin_amdgcn_s_sleep(1); \
    if ((++_sp & 255u) == 0u) { if (xb_ld(&(bar)[XB_TMO])) break; if (_sp > XB_SPIN_CAP) { atomicAdd(&(bar)[XB_TMO], 1u); break; } } } } while (0)
struct XcdBarrier { unsigned* bar; unsigned x; volatile LAS unsigned* st; };
__device__ __forceinline__ XcdBarrier xcd_barrier_post(unsigned* bar, volatile LAS unsigned* st) {
    XcdBarrier b; b.bar = bar; b.x = xb_xcc_id(); b.st = st;
    if (threadIdx.x == 0) (void)xb_add(&bar[XB_XCNT(b.x)], 1u);
    return b;
}
__device__ __forceinline__ void xcd_barrier_complete(unsigned* bar, unsigned x, unsigned& nloc, unsigned& nx) {
    const unsigned G = gridDim.x * gridDim.y * gridDim.z;
    unsigned sum, cnt, mine, sp = 0u;
    for (;;) {
        sum = 0u; cnt = 0u; mine = 0u;
#pragma unroll
        for (unsigned j = 0; j < 16; ++j) { const unsigned c = xb_ld(&bar[XB_XCNT(j)]); sum += c; cnt += (c > 0u) ? 1u : 0u; mine = (j == x) ? c : mine; }
        if (sum == G) break;
        __builtin_amdgcn_s_sleep(1);
        if ((++sp & 255u) == 0u) { if (xb_ld(&bar[XB_TMO])) break; if (sp > XB_SPIN_CAP) { atomicAdd(&bar[XB_TMO], 1u); break; } }
    }
    nloc = mine > 0u ? mine : 1u; nx = cnt > 0u ? cnt : 1u;
}
__device__ __forceinline__ void xcd_barrier(const XcdBarrier& b) {
    asm volatile("s_waitcnt vmcnt(0)" ::: "memory");
    __syncthreads();
    if (threadIdx.x == 0) {
        unsigned* bar = b.bar;
        __builtin_amdgcn_s_waitcnt(0);
        unsigned nloc = b.st[0], nx = b.st[1];
        if (nloc == 0u) { xcd_barrier_complete(bar, b.x, nloc, nx); b.st[0] = nloc; b.st[1] = nx; }
        const unsigned old = xb_add(&bar[XB_XSUB(b.x)], 1u);
        const unsigned gen = old / nloc;
        if (old + 1u == (gen + 1u) * nloc) {
            __builtin_amdgcn_fence(__ATOMIC_RELEASE, "agent");
            asm volatile("s_waitcnt vmcnt(0)" ::: "memory");
            const unsigned og = xb_add(&bar[XB_TOP], 1u);
            const unsigned tg = og / nx;
            if (og + 1u == (tg + 1u) * nx) xb_add(&bar[XB_TOPGEN], 1u);
            else XB_SPIN(xb_ld(&bar[XB_TOPGEN]) == tg, bar);
            __builtin_amdgcn_fence(__ATOMIC_ACQUIRE, "agent");
            xb_add(&bar[XB_XGEN(b.x)], 1u);
            asm volatile("s_waitcnt vmcnt(0)" ::: "memory");
        } else {
            XB_SPIN(xb_ld(&bar[XB_XGEN(b.x)]) == gen, bar);
            __builtin_amdgcn_fence(__ATOMIC_ACQUIRE, "agent");
            asm volatile("s_waitcnt vmcnt(0)" ::: "memory");
        }
    }
    __syncthreads();
}

struct RowInfo { int seq, t, L, pos; };
__device__ __forceinline__ RowInfo rowinfo(int m) {
    RowInfo r;
    if (m < NPROMPT) { r.seq = m >> 11; r.t = m & 2047; r.L = 2048; r.pos = r.t; }
    else { const int q = m - NPROMPT; r.seq = 4 + (q >> 5); r.t = q & 31; r.L = 32; r.pos = 1024 + r.t; }
    return r;
}
__device__ __forceinline__ float wave_sum(float v) {
#pragma unroll
    for (int o = 1; o < 64; o <<= 1) v += __shfl_xor(v, o);
    return v;
}
template <int CTRL> __device__ __forceinline__ float dppmov(float v) {
    return __builtin_bit_cast(float, __builtin_amdgcn_update_dpp(0, __builtin_bit_cast(int, v), CTRL, 0xF, 0xF, true));
}
__device__ __forceinline__ float reduce16(float v) {
    v += dppmov<0xB1>(v); v += dppmov<0x4E>(v); v += dppmov<0x141>(v); v += dppmov<0x140>(v);
    return v;
}
__device__ __forceinline__ float sigmoidf_(float z) { return 1.0f / (1.0f + __expf(-z)); }
__device__ __forceinline__ int rho_of_d(int d) { return 8 * ((d & 31) >> 2) + 4 * (d >> 5) + (d & 3); }

__device__ __forceinline__ const float* inptr(int k) {
    const char __attribute__((address_space(4)))* kp = (const char __attribute__((address_space(4)))*)__builtin_amdgcn_kernarg_segment_ptr();
    asm volatile("" : "+s"(kp));
    return *(const float* const __attribute__((address_space(4)))*)(kp + 8 * k);
}
struct Frame {
    LAS unsigned char* lds;
    volatile LAS unsigned* MISC;
    gu32* ctl;
    int wave, vcu, G;
    float* out;
    unsigned char* ws;
};

template <int MAPMODE>
__device__ __forceinline__ void transpose_item(const float* W, int K, int N, bf16* WT, LAS float* scr, int item, int lane) {
    const int nblk = N / 32, kb = item / nblk, nb = item % nblk, k0 = 64 * kb, n0 = 32 * nb;
#pragma unroll 8
    for (int i = 0; i < 32; ++i) { const int kk = 2 * i + (lane >> 5); scr[kk * 33 + (lane & 31)] = W[(size_t)(k0 + kk) * N + n0 + (lane & 31)]; }
    LDS_WAIT(); asm volatile("" ::: "memory");
    const int c = lane & 7;
#pragma unroll
    for (int j = 0; j < 4; ++j) { const int n = (lane >> 3) + 8 * j; const LAS float* s = scr + (8 * c) * 33 + n;
        v4u o; o.x = pk2(s[0 * 33], s[1 * 33]); o.y = pk2(s[2 * 33], s[3 * 33]); o.z = pk2(s[4 * 33], s[5 * 33]); o.w = pk2(s[6 * 33], s[7 * 33]);
        int row = n0 + n;
        if (MAPMODE == 1) { if (row < 1152) row = (row & ~63) | rho_of_d(row & 63); }
        *(GAS v4u*)(WT + (size_t)row * K + k0 + 8 * c) = o; }
    LDS_WAIT(); asm volatile("" ::: "memory");
}
template <bool WF, bool WB>
__device__ __forceinline__ void ln_row(const float* src, const float* g, const float* b, float* dstf, bf16* dstb, int lane, const float* slab = nullptr, int nslab = 0) {
    const GAS f32x4* xr = (const GAS f32x4*)src + lane;
    f32x4 v[8]; float s = 0.f;
#pragma unroll
    for (int j = 0; j < 8; ++j) v[j] = xr[64 * j];
    if (nslab > 0) {
#pragma unroll
        for (int j = 0; j < 8; ++j) v[j] = v[j] * ALPHA;
        for (int k = 0; k < nslab; ++k) { const GAS f32x4* sr = (const GAS f32x4*)(slab + (size_t)k * 256 * DM) + lane;
#pragma unroll
            for (int j = 0; j < 8; ++j) v[j] = v[j] + sr[64 * j]; }
    }
#pragma unroll
    for (int j = 0; j < 8; ++j) s += (v[j].x + v[j].y) + (v[j].z + v[j].w);
    const float mean = wave_sum(s) * (1.f / DM); float s2 = 0.f;
#pragma unroll
    for (int j = 0; j < 8; ++j) { v[j] = v[j] - mean; s2 += (v[j].x * v[j].x + v[j].y * v[j].y) + (v[j].z * v[j].z + v[j].w * v[j].w); }
    const float rstd = 1.f / sqrtf(wave_sum(s2) * (1.f / DM) + LN_EPS);
#pragma unroll
    for (int j = 0; j < 8; ++j) {
        const f32x4 gg = ((const GAS f32x4*)g)[lane + 64 * j], bb = ((const GAS f32x4*)b)[lane + 64 * j];
        const f32x4 o = v[j] * rstd * gg + bb;
        if (WF) ((GAS f32x4*)dstf)[lane + 64 * j] = o;
        if (WB) { v2u w; w.x = pk2(o.x, o.y); w.y = pk2(o.z, o.w); ((GAS v2u*)dstb)[lane + 64 * j] = w; }
    }
}
__device__ __forceinline__ const float* xrow_ptr(const Frame& F, int m) { return m < NPROMPT ? inptr(0) + (size_t)m * DM : inptr(1) + (size_t)(m - NPROMPT) * DM; }

__device__ __forceinline__ void phase_p0(Frame& F) {
    LAS float* scr = (LAS float*)(F.lds + F.wave * 16384);
    const int gw = F.vcu * NWAVES + F.wave, NGW = F.G * NWAVES;
    const int gt = gw * 64 + ((int)threadIdx.x & 63), NGT = NGW * 64;
    bf16* bt1 = (bf16*)(F.ws + WS_BT1); bf16* bt2 = (bf16*)(F.ws + WS_BT2);
    constexpr int I_IN = (DM / 64) * (INC / 32), I_OUT = (DM / 64) * (DM / 32);
    for (int it = gw; it < I_IN + I_OUT; it += NGW) {
        if (it < I_IN) transpose_item<1>(inptr(9), DM, INC, bt1, scr, it, ((int)threadIdx.x & 63));
        else transpose_item<0>(inptr(22), DM, DM, bt2, scr, it - I_IN, ((int)threadIdx.x & 63));
    }
    { GAS v4u* z = (GAS v4u*)(bt1 + (size_t)INC * DM); const int nz = (N1 - INC) * DM * 2 / 16;
      for (int i = gt; i < nz; i += NGT) z[i] = (v4u){0u, 0u, 0u, 0u}; }
    { bf16* btd = (bf16*)(F.ws + WS_BTD); bf16* bta = (bf16*)(F.ws + WS_BTA); bf16* btg = (bf16*)(F.ws + WS_BTG);
      for (int i = gt; i < 1024 * 128; i += NGT) { const int n = i >> 7, k = i & 127;
          btd[i] = (bf16)(k < 64 ? f2bf(inptr(13)[k * 1024 + n]) : 0u); bta[i] = (bf16)(k < 64 ? f2bf(inptr(15)[k * 1024 + n]) : 0u); }
      for (int i = gt; i < 1024 * 256; i += NGT) { const int n = i >> 8, k = i & 255; btg[i] = (bf16)(k < 160 ? f2bf(inptr(16)[k * 1024 + n]) : 0u); } }
    { float* rope = (float*)(F.ws + WS_ROPE);
      for (int i = gt; i < 2048 * 32; i += NGT) { const int pos = i >> 5, f = i & 31;
          const float inv = powf(10000.0f, -(float)f / 32.0f); const float ang = (float)pos * inv; float sn, cs; sincosf(ang, &sn, &cs);
          rope[pos * 64 + f] = cs; rope[pos * 64 + 32 + f] = sn; } }
    { const float* ck = inptr(2); const float* cv = inptr(3);
      for (int i = gt; i < 8 * 96 * 128 / 4; i += NGT) { const int sb = i / (96 * 32), r = i % (96 * 32);
          ((GAS f32x4*)(F.out + O_SK + (size_t)sb * 128 * 128))[r] = ((const GAS f32x4*)(ck + (size_t)sb * 128 * 128 + 32 * 128))[r];
          ((GAS f32x4*)(F.out + O_SV + (size_t)sb * 128 * 128))[r] = ((const GAS f32x4*)(cv + (size_t)sb * 128 * 128 + 32 * 128))[r]; } }
    { const float* ck = inptr(2); const float* cv = inptr(3); bf16* kb = (bf16*)(F.ws + WS_KB) + KB_SAMP; bf16* vt = (bf16*)(F.ws + WS_VT) + VT_SAMP;
      for (int i = gt; i < 8 * 128 * 128; i += NGT) { const int sb = i >> 14, key = (i >> 7) & 127, c = i & 127, kvh = c >> 6, d = c & 63;
          kb[((size_t)sb * 160 + key) * 128 + kvh * 64 + rho_of_d(d)] = (bf16)f2bf(ck[i]);
          vt[((size_t)sb * 128 + c) * 160 + key] = (bf16)f2bf(cv[i]); } }
    { bf16* h0b = (bf16*)(F.ws + WS_H0B);
      for (int m = gw; m < NTOK; m += NGW) ln_row<true, true>(xrow_ptr(F, m), inptr(7), inptr(8), F.out + O_Y + (size_t)m * DM, h0b + (size_t)m * DM, ((int)threadIdx.x & 63)); }
}

using pg8::Unit;
#define EPI_ROWS_BEGIN  _Pragma("unroll") for (int ai = 0; ai < 2; ++ai) _Pragma("unroll") for (int m = 0; m < 4; ++m) { const int row = u.pm * 256 + ai * 128 + wr * 64 + m * 16 + fr;
#define EPI_ROWS_END }
struct EpiIn {
    static constexpr bool PERM = true;
    bf16* mix; bf16* kb; bf16* vb; bf16* prw; const float* rope; float* out;
    __device__ __forceinline__ void operator()(const f32x4 (&acc)[2][2][4][2], const Unit& u, int wr, int wc, int fr, int fq) const {
        const int cw = wc * 32 + 8 * fq;
        if (u.pn < 4) {
            const int d0 = 4 * (((cw & 63) >> 3));
            EPI_ROWS_BEGIN
                const RowInfo ri = rowinfo(row);
                const f32x4 cs = *(const GAS f32x4*)(rope + ri.pos * 64 + d0), sn = *(const GAS f32x4*)(rope + ri.pos * 64 + 32 + d0);
#pragma unroll
                for (int bj = 0; bj < 2; ++bj) {
                    const f32x4 x1 = acc[ai][bj][m][0], x2 = acc[ai][bj][m][1];
                    const f32x4 o1 = (x1 * cs - x2 * sn) * 0.125f, o2 = (x2 * cs + x1 * sn) * 0.125f;
                    v4u w; w.x = pk2(o1.x, o1.y); w.y = pk2(o1.z, o1.w); w.z = pk2(o2.x, o2.y); w.w = pk2(o2.z, o2.w);
                    *(GAS v4u*)(mix + (size_t)row * DM + u.pn * 256 + bj * 128 + cw) = w;
                }
            EPI_ROWS_END
        } else if (u.pn == 4) {
            const int kvh = cw >> 6, d0 = 4 * ((cw & 63) >> 3);
            EPI_ROWS_BEGIN
                const RowInfo ri = rowinfo(row);
                const int wrow = ri.t - (ri.L - 128);
                const bool smp = ri.seq >= 4;
                float* ok = !smp ? out + O_PK + (size_t)ri.seq * 128 * 128 : out + O_SK + (size_t)(ri.seq - 4) * 128 * 128;
                float* ov = !smp ? out + O_PV + (size_t)ri.seq * 128 * 128 : out + O_SV + (size_t)(ri.seq - 4) * 128 * 128;
                {
                    const f32x4 cs = *(const GAS f32x4*)(rope + ri.pos * 64 + d0), sn = *(const GAS f32x4*)(rope + ri.pos * 64 + 32 + d0);
                    const f32x4 x1 = acc[ai][0][m][0], x2 = acc[ai][0][m][1];
                    const f32x4 o1 = x1 * cs - x2 * sn, o2 = x2 * cs + x1 * sn;
                    v4u w; w.x = pk2(o1.x, o1.y); w.y = pk2(o1.z, o1.w); w.z = pk2(o2.x, o2.y); w.w = pk2(o2.z, o2.w);
                    bf16* kdst = !smp ? kb + (size_t)row * 128 + cw : kb + KB_SAMP + ((size_t)(ri.seq - 4) * 160 + 128 + ri.t) * 128 + cw;
                    *(GAS v4u*)kdst = w;
                    if (wrow >= 0) { *(GAS f32x4*)(ok + (size_t)wrow * 128 + kvh * 64 + d0) = o1; *(GAS f32x4*)(ok + (size_t)wrow * 128 + kvh * 64 + 32 + d0) = o2; }
                }
                {
                    const f32x4 x1 = acc[ai][1][m][0], x2 = acc[ai][1][m][1];
                    bf16* vdst = !smp ? vb + ((size_t)ri.seq * 128 + cw) * 2048 + ri.t : vb + VT_SAMP + ((size_t)(ri.seq - 4) * 128 + cw) * 160 + 128 + ri.t;
                    const size_t ldv = !smp ? 2048 : 160;
                    vdst[0 * ldv] = (bf16)f2bf(x1.x); vdst[1 * ldv] = (bf16)f2bf(x1.y); vdst[2 * ldv] = (bf16)f2bf(x1.z); vdst[3 * ldv] = (bf16)f2bf(x1.w);
                    vdst[4 * ldv] = (bf16)f2bf(x2.x); vdst[5 * ldv] = (bf16)f2bf(x2.y); vdst[6 * ldv] = (bf16)f2bf(x2.z); vdst[7 * ldv] = (bf16)f2bf(x2.w);
                    if (wrow >= 0) { *(GAS f32x4*)(ov + (size_t)wrow * 128 + cw) = x1; *(GAS f32x4*)(ov + (size_t)wrow * 128 + cw + 4) = x2; }
                }
            EPI_ROWS_END
        } else {
            EPI_ROWS_BEGIN
                const RowInfo ri = rowinfo(row);
                float* osh = (ri.seq < 4) ? out + O_PSHIFT + (size_t)ri.seq * RWC : out + O_SSHIFT + (size_t)(ri.seq - 4) * RWC;
#pragma unroll
                for (int bj = 0; bj < 2; ++bj) {
                    const int col = (u.pn - 5) * 256 + bj * 128 + cw;
                    if (col < RWC) {
                        const f32x4 x1 = acc[ai][bj][m][0], x2 = acc[ai][bj][m][1];
                        v4u w; w.x = pk2(x1.x, x1.y); w.y = pk2(x1.z, x1.w); w.z = pk2(x2.x, x2.y); w.w = pk2(x2.z, x2.w);
                        *(GAS v4u*)(prw + (size_t)row * PRW_LD + col) = w;
                        if (ri.t == ri.L - 1) { *(GAS f32x4*)(osh + col) = x1; *(GAS f32x4*)(osh + col + 4) = x2; }
                    }
                }
            EPI_ROWS_END
        }
    }
};
struct EpiDecay {
    static constexpr bool PERM = true;
    float* rec; const float* w0;
    __device__ __forceinline__ void operator()(const f32x4 (&acc)[2][2][4][2], const Unit& u, int wr, int wc, int fr, int fq) const {
        EPI_ROWS_BEGIN
#pragma unroll
            for (int bj = 0; bj < 2; ++bj) {
                const int c = u.pn * 256 + bj * 128 + wc * 32 + 8 * fq, h = c >> 6, j = c & 63;
                float* dst = rec + ((size_t)row * 16 + h) * 320 + 2 * 64 + j;
#pragma unroll
                for (int n = 0; n < 2; ++n) { const f32x4 z = acc[ai][bj][m][n] + *(const GAS f32x4*)(w0 + c + 4 * n); f32x4 o;
                    o.x = __expf(-0.6065306597126334f * sigmoidf_(z.x)); o.y = __expf(-0.6065306597126334f * sigmoidf_(z.y));
                    o.z = __expf(-0.6065306597126334f * sigmoidf_(z.z)); o.w = __expf(-0.6065306597126334f * sigmoidf_(z.w));
                    *(GAS f32x4*)(dst + 4 * n) = o; }
            }
        EPI_ROWS_END
    }
};
template <int MODE>
struct EpiVec {
    static constexpr bool PERM = true;
    bf16* dst; const float* bias;
    __device__ __forceinline__ void operator()(const f32x4 (&acc)[2][2][4][2], const Unit& u, int wr, int wc, int fr, int fq) const {
        EPI_ROWS_BEGIN
#pragma unroll
            for (int bj = 0; bj < 2; ++bj) {
                const int c = u.pn * 256 + bj * 128 + wc * 32 + 8 * fq;
                f32x4 x1 = acc[ai][bj][m][0], x2 = acc[ai][bj][m][1];
                if (MODE == 0) { x1 = x1 + *(const GAS f32x4*)(bias + c); x2 = x2 + *(const GAS f32x4*)(bias + c + 4);
                    x1.x = sigmoidf_(x1.x); x1.y = sigmoidf_(x1.y); x1.z = sigmoidf_(x1.z); x1.w = sigmoidf_(x1.w);
                    x2.x = sigmoidf_(x2.x); x2.y = sigmoidf_(x2.y); x2.z = sigmoidf_(x2.z); x2.w = sigmoidf_(x2.w); }
                v4u w; w.x = pk2(x1.x, x1.y); w.y = pk2(x1.z, x1.w); w.z = pk2(x2.x, x2.y); w.w = pk2(x2.z, x2.w);
                *(GAS v4u*)(dst + (size_t)row * 1024 + c) = w;
            }
        EPI_ROWS_END
    }
};
struct EpiRes {
    static constexpr bool PERM = true;
    float* y;
    __device__ __forceinline__ void operator()(const f32x4 (&acc)[2][2][4][2], const Unit& u, int wr, int wc, int fr, int fq) const {
        EPI_ROWS_BEGIN
#pragma unroll
            for (int bj = 0; bj < 2; ++bj) {
                const int c = u.pn * 256 + bj * 128 + wc * 32 + 8 * fq;
                GAS f32x4* p = (GAS f32x4*)(y + (size_t)row * DM + c);
                const f32x4 r0 = p[0], r1 = p[1];
                p[0] = r0 * ALPHA + acc[ai][bj][m][0]; p[1] = r1 * ALPHA + acc[ai][bj][m][1];
            }
        EPI_ROWS_END
    }
};
struct EpiSlab {
    static constexpr bool PERM = true;
    float* slab;
    __device__ __forceinline__ void operator()(const f32x4 (&acc)[2][2][4][2], const Unit& u, int wr, int wc, int fr, int fq) const {
        float* sl = slab + (size_t)u.ks * 256 * DM;
#pragma unroll
        for (int ai = 0; ai < 2; ++ai)
#pragma unroll
            for (int m = 0; m < 4; ++m) { const int lr = ai * 128 + wr * 64 + m * 16 + fr;
#pragma unroll
                for (int bj = 0; bj < 2; ++bj) { const int c = u.pn * 256 + bj * 128 + wc * 32 + 8 * fq; GAS f32x4* p = (GAS f32x4*)(sl + (size_t)lr * DM + c); p[0] = acc[ai][bj][m][0]; p[1] = acc[ai][bj][m][1]; } }
    }
};
struct EpiUp {
    static constexpr bool PERM = true;
    bf16* up; float* out;
    __device__ __forceinline__ void operator()(const f32x4 (&acc)[2][2][4][2], const Unit& u, int wr, int wc, int fr, int fq) const {
        EPI_ROWS_BEGIN
            const RowInfo ri = rowinfo(row);
            const int cr = ri.t - (ri.L - 2);
            float* oc = (ri.seq < 4) ? out + O_PCONV + (size_t)ri.seq * 2 * NUP : out + O_SCONV + (size_t)(ri.seq - 4) * 2 * NUP;
#pragma unroll
            for (int bj = 0; bj < 2; ++bj) {
                const int c = u.pn * 256 + bj * 128 + wc * 32 + 8 * fq;
                const f32x4 x1 = acc[ai][bj][m][0], x2 = acc[ai][bj][m][1];
                v4u w; w.x = pk2(x1.x, x1.y); w.y = pk2(x1.z, x1.w); w.z = pk2(x2.x, x2.y); w.w = pk2(x2.z, x2.w);
                *(GAS v4u*)(up + (size_t)row * NUP + c) = w;
                if (cr >= 0) { *(GAS f32x4*)(oc + (size_t)cr * NUP + c) = x1; *(GAS f32x4*)(oc + (size_t)cr * NUP + c + 4) = x2; }
            }
        EPI_ROWS_END
    }
};

__device__ __forceinline__ void phase_prep_a(Frame& F) {
    const int gw = F.vcu * NWAVES + F.wave, NGW = F.G * NWAVES, l = ((int)threadIdx.x & 63);
    const bf16* prw = (const bf16*)(F.ws + WS_PRW); bf16* al = (bf16*)(F.ws + WS_ALORA);
    const float* mu = inptr(11); const float* sshift = inptr(5);
    int src = -1, mode = 0;
    if (l < 8) { src = RC_WD + 8 * l; mode = 1; } else if (l >= 16 && l < 24) { src = RC_AD + 8 * (l - 16); mode = 2; } else if (l >= 32 && l < 52) { src = RC_GD + 8 * (l - 32); mode = 3; }
    for (int m = gw; m < NTOK; m += NGW) {
        v4u o = (v4u){0u, 0u, 0u, 0u};
        if (src >= 0) {
            const RowInfo ri = rowinfo(m);
            const v4u pc = *(const GAS v4u*)(prw + (size_t)m * PRW_LD + src);
            float p[8] = {bf_lo(pc.x), bf_hi(pc.x), bf_lo(pc.y), bf_hi(pc.y), bf_lo(pc.z), bf_hi(pc.z), bf_lo(pc.w), bf_hi(pc.w)};
            float pv[8];
            if (ri.t > 0) { const v4u pp = *(const GAS v4u*)(prw + (size_t)(m - 1) * PRW_LD + src);
                pv[0] = bf_lo(pp.x); pv[1] = bf_hi(pp.x); pv[2] = bf_lo(pp.y); pv[3] = bf_hi(pp.y); pv[4] = bf_lo(pp.z); pv[5] = bf_hi(pp.z); pv[6] = bf_lo(pp.w); pv[7] = bf_hi(pp.w); }
            else if (ri.seq >= 4) {
#pragma unroll
                for (int i = 0; i < 8; ++i) pv[i] = sshift[(size_t)(ri.seq - 4) * RWC + src + i]; }
            else {
#pragma unroll
                for (int i = 0; i < 8; ++i) pv[i] = 0.f; }
            float x[8];
#pragma unroll
            for (int i = 0; i < 8; ++i) { const float xs = p[i] + (pv[i] - p[i]) * mu[src + i];
                x[i] = mode == 1 ? tanhf(xs) : (mode == 3 ? sigmoidf_(xs) : xs); }
            o.x = pk2(x[0], x[1]); o.y = pk2(x[2], x[3]); o.z = pk2(x[4], x[5]); o.w = pk2(x[6], x[7]);
        }
        *(GAS v4u*)(al + (size_t)m * 512 + 8 * l) = o;
    }
}

__device__ __forceinline__ void phase_prep_b(Frame& F) {
    const int gw = F.vcu * NWAVES + F.wave, NGW = F.G * NWAVES, l = ((int)threadIdx.x & 63);
    const bf16* prw = (const bf16*)(F.ws + WS_PRW); const bf16* asig = (const bf16*)(F.ws + WS_ASIG);
    float* rec = (float*)(F.ws + WS_REC); bf16* vcopy = (bf16*)(F.ws + WS_VCOPY); float* rkr = (float*)(F.ws + WS_RKR);
    const float* mu = inptr(11); const float* sshift = inptr(5);
    for (int it = gw; it < NTOK * 4; it += NGW) {
        const int m = it >> 2, q4 = it & 3, c = 256 * q4 + 4 * l, h = c >> 6, j = c & 63;
        const RowInfo ri = rowinfo(m);
        float xr[4], xk[4], xv[4];
#pragma unroll
        for (int part = 0; part < 3; ++part) {
            const int col = (part == 0 ? RC_R : (part == 1 ? RC_K : RC_V)) + c;
            const v2u pc = *(const GAS v2u*)(prw + (size_t)m * PRW_LD + col);
            const float p[4] = {bf_lo(pc.x), bf_hi(pc.x), bf_lo(pc.y), bf_hi(pc.y)};
            float pv[4];
            if (ri.t > 0) { const v2u pp = *(const GAS v2u*)(prw + (size_t)(m - 1) * PRW_LD + col); pv[0] = bf_lo(pp.x); pv[1] = bf_hi(pp.x); pv[2] = bf_lo(pp.y); pv[3] = bf_hi(pp.y); }
            else if (ri.seq >= 4) { const f32x4 s = *(const GAS f32x4*)(sshift + (size_t)(ri.seq - 4) * RWC + col); pv[0] = s.x; pv[1] = s.y; pv[2] = s.z; pv[3] = s.w; }
            else { pv[0] = pv[1] = pv[2] = pv[3] = 0.f; }
            const f32x4 mm = *(const GAS f32x4*)(mu + col);
            const float mv[4] = {mm.x, mm.y, mm.z, mm.w};
#pragma unroll
            for (int i = 0; i < 4; ++i) { const float xs = p[i] + (pv[i] - p[i]) * mv[i]; if (part == 0) xr[i] = xs; else if (part == 1) xk[i] = xs; else xv[i] = xs; }
        }
        const v2u ac = *(const GAS v2u*)(asig + (size_t)m * 1024 + c);
        const float a[4] = {bf_lo(ac.x), bf_hi(ac.x), bf_lo(ac.y), bf_hi(ac.y)};
        const f32x4 kkw = *(const GAS f32x4*)(inptr(17) + c), kaw = *(const GAS f32x4*)(inptr(18) + c), rkw = *(const GAS f32x4*)(inptr(19) + c);
        const float kkv[4] = {kkw.x, kkw.y, kkw.z, kkw.w}, kav[4] = {kaw.x, kaw.y, kaw.z, kaw.w}, rkv[4] = {rkw.x, rkw.y, rkw.z, rkw.w};
        float kk[4], kp[4]; float ss = 0.f, rs = 0.f;
#pragma unroll
        for (int i = 0; i < 4; ++i) { kk[i] = xk[i] * kkv[i]; ss += kk[i] * kk[i]; kp[i] = xk[i] * (1.0f + (a[i] - 1.0f) * kav[i]); rs += xr[i] * kp[i] * rkv[i]; }
        ss = reduce16(ss); rs = reduce16(rs);
        const float inv = 1.0f / fmaxf(sqrtf(ss), 1e-12f);
        float* rp = rec + ((size_t)m * 16 + h) * 320 + j;
        f32x4 A, B;
        A.x = -kk[0] * inv; A.y = -kk[1] * inv; A.z = -kk[2] * inv; A.w = -kk[3] * inv;
        B.x = -A.x * a[0]; B.y = -A.y * a[1]; B.z = -A.z * a[2]; B.w = -A.w * a[3];
        *(GAS f32x4*)(rp) = A;
        *(GAS f32x4*)(rp + 64) = (f32x4){xr[0], xr[1], xr[2], xr[3]};
        *(GAS f32x4*)(rp + 192) = B;
        *(GAS f32x4*)(rp + 256) = (f32x4){kp[0], kp[1], kp[2], kp[3]};
        v2u vw; vw.x = pk2(xv[0], xv[1]); vw.y = pk2(xv[2], xv[3]);
        *(GAS v2u*)(vcopy + (size_t)m * 1024 + c) = vw;
        if ((l & 15) == 0) rkr[m * 16 + h] = rs;
    }
}

__device__ __forceinline__ void attn_item(Frame& F, int item) {
    const bf16* kb = (const bf16*)(F.ws + WS_KB); const bf16* vt = (const bf16*)(F.ws + WS_VT); bf16* mix = (bf16*)(F.ws + WS_MIX);
    const int lane = (int)threadIdx.x & 63, r = lane & 31, h = lane >> 5;
    int row0, nqt, nkt, hq; const bf16* K0; const bf16* V0; int ldv;
    if (item < 2048) { const int b = item >> 9, n = (item >> 4) & 31; hq = item & 15; row0 = b * 2048 + 64 * n; nqt = 2; const int back = n < 2 ? n : 2; nkt = 2 * (back + 1);
        K0 = kb + (size_t)(row0 - 64 * back) * 128; V0 = vt + (size_t)b * 128 * 2048 + (64 * (n - back)); ldv = 2048; }
    else { const int j = item - 2048, sb = j >> 4; hq = j & 15; row0 = NPROMPT + 32 * sb; nqt = 1; nkt = 5; K0 = kb + KB_SAMP + (size_t)sb * 160 * 128; V0 = vt + VT_SAMP + (size_t)sb * 128 * 160; ldv = 160; }
    const int kvh = hq >> 3;
    K0 += kvh * 64; V0 += (size_t)kvh * 64 * ldv;
    const float sink = inptr(10)[hq];
    for (int qt = 0; qt < nqt; ++qt) {
        bf16* qrow = mix + (size_t)(row0 + 32 * qt + r) * DM + hq * 64;
        bf16x8 qf[4];
#pragma unroll
        for (int ds = 0; ds < 4; ++ds) qf[ds] = *(const GAS bf16x8*)(qrow + 16 * ds + 8 * h);
        f32x16 X[6];
#pragma unroll
        for (int kt = 0; kt < 6; ++kt) {
#pragma unroll
            for (int e = 0; e < 16; ++e) X[kt][e] = 0.f;
            if (kt < nkt) {
#pragma unroll
                for (int ds = 0; ds < 4; ++ds) { const bf16x8 kf = *(const GAS bf16x8*)(K0 + (size_t)(32 * kt + r) * 128 + 16 * ds + 8 * h);
                    X[kt] = __builtin_amdgcn_mfma_f32_32x32x16_bf16(kf, qf[ds], X[kt], 0, 0, 0); }
            }
        }
        float mx = sink;
#pragma unroll
        for (int kt = 0; kt < 6; ++kt) if (kt < nkt) {
#pragma unroll
            for (int e = 0; e < 16; ++e) mx = fmaxf(mx, X[kt][e]); }
        mx = fmaxf(mx, __shfl_xor(mx, 32));
        float sum = 0.f;
#pragma unroll
        for (int kt = 0; kt < 6; ++kt) if (kt < nkt) {
#pragma unroll
            for (int e = 0; e < 16; ++e) { const float p = __expf(X[kt][e] - mx); X[kt][e] = p; sum += p; } }
        sum += __shfl_xor(sum, 32);
        const float invden = 1.0f / (sum + __expf(sink - mx));
        f32x16 O[2];
#pragma unroll
        for (int dt = 0; dt < 2; ++dt)
#pragma unroll
            for (int e = 0; e < 16; ++e) O[dt][e] = 0.f;
#pragma unroll
        for (int kt = 0; kt < 6; ++kt) if (kt < nkt) {
#pragma unroll
            for (int s = 0; s < 2; ++s) {
                v4u pw; pw.x = pk2(X[kt][8 * s + 0], X[kt][8 * s + 1]); pw.y = pk2(X[kt][8 * s + 2], X[kt][8 * s + 3]); pw.z = pk2(X[kt][8 * s + 4], X[kt][8 * s + 5]); pw.w = pk2(X[kt][8 * s + 6], X[kt][8 * s + 7]);
                const bf16x8 pb = __builtin_bit_cast(bf16x8, pw);
#pragma unroll
                for (int dt = 0; dt < 2; ++dt) {
                    const bf16* vp = V0 + (size_t)(32 * dt + r) * ldv + 32 * kt + 16 * s + 4 * h;
                    const v2u a0 = *(const GAS v2u*)(vp), a1 = *(const GAS v2u*)(vp + 8);
                    v4u aw; aw.x = a0.x; aw.y = a0.y; aw.z = a1.x; aw.w = a1.y;
                    O[dt] = __builtin_amdgcn_mfma_f32_32x32x16_bf16(__builtin_bit_cast(bf16x8, aw), pb, O[dt], 0, 0, 0);
                }
            }
        }
#pragma unroll
        for (int dt = 0; dt < 2; ++dt)
#pragma unroll
            for (int g4 = 0; g4 < 4; ++g4) {
                v2u w; w.x = pk2(O[dt][4 * g4 + 0] * invden, O[dt][4 * g4 + 1] * invden); w.y = pk2(O[dt][4 * g4 + 2] * invden, O[dt][4 * g4 + 3] * invden);
                *(GAS v2u*)(qrow + 32 * dt + 8 * g4 + 4 * h) = w;
            }
    }
}

constexpr int SC_BUF = 32 * 5 * 64 * 4 + 32 * 16 * 4;
constexpr int HELP_OFF = 90112, HELP_STRIDE = 8704;
__device__ __forceinline__ void grp_barrier(volatile LAS unsigned* cnt, unsigned& epoch) {
    epoch += 4u;
    asm volatile("s_waitcnt vmcnt(0) lgkmcnt(0)" ::: "memory");
    if (((int)threadIdx.x & 63) == 0) __hip_atomic_fetch_add((LAS unsigned*)cnt, 1u, __ATOMIC_RELAXED, __HIP_MEMORY_SCOPE_WORKGROUP);
    for (unsigned sp = 0; (int)(*cnt - epoch) < 0 && sp < (1u << 24); ++sp) __builtin_amdgcn_s_sleep(1);
    asm volatile("" ::: "memory");
}
__device__ __forceinline__ void scan_job(Frame& F, int m0, int T, int hh, int q, const float* s_in, float* s_out, unsigned& epoch) {
    const float* rec = (const float*)(F.ws + WS_REC); const bf16* vcopy = (const bf16*)(F.ws + WS_VCOPY); float* og = (float*)(F.ws + WS_O);
    volatile LAS unsigned* cnt = F.MISC + 16;
    const int tid = (int)threadIdx.x & 255, lane = tid & 63, wave = F.wave;
    const int st = tid >> 3, p8 = tid & 7;
    const int nch = T / 32;
    f32x4 rg[5][2]; float vr[2];
#define SC_LOAD(c_) do { const size_t m_ = (size_t)(m0 + 32 * (c_) + st); const float* rp_ = rec + (m_ * 16 + hh) * 320 + p8 * 4; \
        _Pragma("unroll") for (int k = 0; k < 5; ++k) { rg[k][0] = *(const GAS f32x4*)(rp_ + k * 64); rg[k][1] = *(const GAS f32x4*)(rp_ + k * 64 + 32); } \
        vr[0] = __builtin_bit_cast(float, (unsigned)vcopy[m_ * 1024 + hh * 64 + 16 * q + p8] << 16); vr[1] = __builtin_bit_cast(float, (unsigned)vcopy[m_ * 1024 + hh * 64 + 16 * q + p8 + 8] << 16); } while (0)
#define SC_WRITE(b_) do { LAS float* buf_ = (LAS float*)(F.lds + (b_) * SC_BUF); \
        _Pragma("unroll") for (int k = 0; k < 5; ++k) { *(LAS f32x4*)(buf_ + (st * 5 + k) * 64 + p8 * 4) = rg[k][0]; *(LAS f32x4*)(buf_ + (st * 5 + k) * 64 + p8 * 4 + 32) = rg[k][1]; } \
        buf_[32 * 320 + st * 16 + p8] = vr[0]; buf_[32 * 320 + st * 16 + p8 + 8] = vr[1]; } while (0)
    const int rgp = lane >> 4, cl = lane & 15, irow = 16 * q + 4 * wave + rgp, j0 = 4 * cl;
    f32x4 S = (f32x4){0.f, 0.f, 0.f, 0.f};
    if (s_in) S = *(const GAS f32x4*)(s_in + (size_t)irow * 64 + j0);
    grp_barrier(cnt, epoch);
    SC_LOAD(0); SC_WRITE(0);
    if (nch > 1) SC_LOAD(1);
    for (int c = 0; c < nch; ++c) {
        grp_barrier(cnt, epoch);
        if (c + 1 < nch) SC_WRITE((c + 1) & 1);
        if (c + 2 < nch) SC_LOAD(c + 2);
        {
            const LAS float* buf = (const LAS float*)(F.lds + (c & 1) * SC_BUF);
            const LAS float* bp = buf + j0;
            const LAS float* vp = buf + 32 * 320 + 4 * wave + rgp;
            float* op = og + (size_t)(m0 + 32 * c + cl) * 1024 + hh * 64 + irow;
            f32x4 A = *(const LAS f32x4*)(bp), R = *(const LAS f32x4*)(bp + 64), W = *(const LAS f32x4*)(bp + 128), B = *(const LAS f32x4*)(bp + 192), Kv = *(const LAS f32x4*)(bp + 256);
            float v = vp[0], ov = 0.f, pprev = 0.f;
            f32x2 S01 = (f32x2){S.x, S.y}, S23 = (f32x2){S.z, S.w};
#pragma unroll
            for (int s = 0; s < 32; ++s) {
                f32x4 nA, nR, nW, nB, nK; float nv;
                if (s < 31) { const LAS float* np = bp + (s + 1) * 320;
                    nA = *(const LAS f32x4*)(np); nR = *(const LAS f32x4*)(np + 64); nW = *(const LAS f32x4*)(np + 128); nB = *(const LAS f32x4*)(np + 192); nK = *(const LAS f32x4*)(np + 256); nv = vp[(s + 1) * 16]; }
                __builtin_amdgcn_sched_barrier(0);
                f32x2 t = S01 * (f32x2){A.x, A.y}; t = S23 * (f32x2){A.z, A.w} + t;
                const f32x2 c01 = S01 * (f32x2){W.x, W.y} + (f32x2){Kv.x, Kv.y} * v, c23 = S23 * (f32x2){W.z, W.w} + (f32x2){Kv.z, Kv.w} * v;
                const float sa = reduce16(t.x + t.y);
                if (s > 0) { const float po = reduce16(pprev); ov = (cl == ((s - 1) & 15)) ? po : ov; if (((s - 1) & 15) == 15) op[(size_t)(s - 16) * 1024] = ov; }
                S01 = (f32x2){B.x, B.y} * sa + c01; S23 = (f32x2){B.z, B.w} * sa + c23;
                f32x2 u = S01 * (f32x2){R.x, R.y}; u = S23 * (f32x2){R.z, R.w} + u;
                pprev = u.x + u.y;
                if (s < 31) { A = nA; R = nR; W = nW; B = nB; Kv = nK; v = nv; }
            }
            { const float po = reduce16(pprev); ov = (cl == 15) ? po : ov; op[(size_t)16 * 1024] = ov; }
            S = (f32x4){S01.x, S01.y, S23.x, S23.y};
        }
    }
    *(GAS f32x4*)(s_out + (size_t)irow * 64 + j0) = S;
#undef SC_LOAD
#undef SC_WRITE
}

__device__ __forceinline__ void phase_scan(Frame& F) {
    if (F.wave < 4) {
        unsigned epoch = 0u;
        __builtin_amdgcn_s_setprio(3);
        REP(5) for (int j = F.vcu; j < 256; j += F.G) {
            const int chain = j >> 2, q = j & 3, b = chain >> 4, hh = chain & 15;
            scan_job(F, b * 2048, 2048, hh, q, nullptr, F.out + O_PWKV + ((size_t)(b * 16 + hh)) * 4096, epoch);
        }
        for (int j = F.vcu; j < 512; j += F.G) {
            const int chain = j >> 2, q = j & 3, sb = chain >> 4, hh = chain & 15;
            scan_job(F, NPROMPT + 32 * sb, 32, hh, q, inptr(4) + ((size_t)(sb * 16 + hh)) * 4096, F.out + O_SWKV + ((size_t)(sb * 16 + hh)) * 4096, epoch);
        }
        __builtin_amdgcn_s_setprio(0);
    } else {
        const int hw = F.wave - 4, ghw = F.vcu * 4 + hw, NH = F.G * 4;
        for (int it = ghw; it < 2048 + 128; it += NH) attn_item(F, it);
        LAS float* scr = (LAS float*)(F.lds + HELP_OFF + hw * HELP_STRIDE);
        bf16* bt3 = (bf16*)(F.ws + WS_BT3); bf16* bt4 = (bf16*)(F.ws + WS_BT4);
        constexpr int I_UP = (DM / 64) * (NUP / 32), I_DN = (DFF / 64) * (DM / 32);
        REP(13) for (int it = ghw; it < I_UP + I_DN; it += NH) {
            if (it < I_UP) transpose_item<0>(inptr(25), DM, NUP, bt3, scr, it, (int)threadIdx.x & 63);
            else transpose_item<0>(inptr(28), DFF, DM, bt4, scr, it - I_UP, (int)threadIdx.x & 63);
        }
    }
}

__device__ __forceinline__ void phase_post(Frame& F) {
    const int gw = F.vcu * NWAVES + F.wave, NGW = F.G * NWAVES, l = ((int)threadIdx.x & 63);
    const float* og = (const float*)(F.ws + WS_O); const bf16* vcopy = (const bf16*)(F.ws + WS_VCOPY); const bf16* gb = (const bf16*)(F.ws + WS_G);
    const float* rkr = (const float*)(F.ws + WS_RKR); bf16* mix = (bf16*)(F.ws + WS_MIX);
    for (int it = gw; it < NTOK * 4; it += NGW) {
        const int m = it >> 2, q4 = it & 3, c = 256 * q4 + 4 * l, h = c >> 6;
        const f32x4 o = *(const GAS f32x4*)(og + (size_t)m * 1024 + c);
        const float mo = reduce16((o.x + o.y) + (o.z + o.w)) * (1.0f / 64.0f);
        const f32x4 d = o - mo;
        const float vo = reduce16((d.x * d.x + d.y * d.y) + (d.z * d.z + d.w * d.w)) * (1.0f / 64.0f);
        const float rstd = 1.0f / sqrtf(vo + LNX_EPS);
        const f32x4 lg = *(const GAS f32x4*)(inptr(20) + c), lb = *(const GAS f32x4*)(inptr(21) + c);
        const v2u vc = *(const GAS v2u*)(vcopy + (size_t)m * 1024 + c), gc = *(const GAS v2u*)(gb + (size_t)m * 1024 + c);
        const f32x4 v = (f32x4){bf_lo(vc.x), bf_hi(vc.x), bf_lo(vc.y), bf_hi(vc.y)}, g = (f32x4){bf_lo(gc.x), bf_hi(gc.x), bf_lo(gc.y), bf_hi(gc.y)};
        const float bs = rkr[m * 16 + h];
        const f32x4 res = (d * rstd * lg + lb + v * bs) * g;
        v2u w; w.x = pk2(res.x, res.y); w.y = pk2(res.z, res.w);
        *(GAS v2u*)(mix + (size_t)m * DM + 1024 + c) = w;
    }
}

template <bool WB>
__device__ __forceinline__ void phase_ln(Frame& F, const float* g, const float* b, bf16* dstb, int nslab) {
    const int gw = F.vcu * NWAVES + F.wave, NGW = F.G * NWAVES;
    const float* slab = (const float*)(F.ws + WS_SLAB);
    for (int m = NTOK - 1 - gw; m >= 0; m -= NGW) { float* y = F.out + O_Y + (size_t)m * DM;
        const bool sm = m >= NPROMPT;
        ln_row<true, WB>(y, g, b, y, WB ? dstb + (size_t)m * DM : nullptr, ((int)threadIdx.x & 63), sm ? slab + (size_t)(m - NPROMPT) * DM : nullptr, sm ? nslab : 0); }
}

__device__ __forceinline__ void phase_conv(Frame& F) {
    const int gw = F.vcu * NWAVES + F.wave, NGW = F.G * NWAVES, l = ((int)threadIdx.x & 63);
    const bf16* up = (const bf16*)(F.ws + WS_UP); bf16* act = (bf16*)(F.ws + WS_ACT);
    const float* cw = inptr(26); const float* cb = inptr(27); const float* sconv = inptr(6);
    constexpr int NRUN = NTOK / 16, NCG = DFF / 512;
    for (int it = gw; it < NRUN * NCG; it += NGW) {
        const int run = it / NCG, cgp = it % NCG, m0 = run * 16, j0 = cgp * 512 + 8 * l;
        const RowInfo ri = rowinfo(m0);
        float wg[3][8], wv[3][8], bg[8], bv[8];
#pragma unroll
        for (int i = 0; i < 3; ++i)
#pragma unroll
            for (int e = 0; e < 8; e += 4) { const f32x4 a = *(const GAS f32x4*)(cw + (size_t)i * NUP + j0 + e), b = *(const GAS f32x4*)(cw + (size_t)i * NUP + DFF + j0 + e);
                wg[i][e] = a.x; wg[i][e + 1] = a.y; wg[i][e + 2] = a.z; wg[i][e + 3] = a.w; wv[i][e] = b.x; wv[i][e + 1] = b.y; wv[i][e + 2] = b.z; wv[i][e + 3] = b.w; }
#pragma unroll
        for (int e = 0; e < 8; e += 4) { const f32x4 a = *(const GAS f32x4*)(cb + j0 + e), b = *(const GAS f32x4*)(cb + DFF + j0 + e);
            bg[e] = a.x; bg[e + 1] = a.y; bg[e + 2] = a.z; bg[e + 3] = a.w; bv[e] = b.x; bv[e + 1] = b.y; bv[e + 2] = b.z; bv[e + 3] = b.w; }
        float g2[8], g1[8], v2[8], v1[8];
        if (ri.t == 0) {
            if (ri.seq >= 4) { const float* sp = sconv + (size_t)(ri.seq - 4) * 2 * NUP;
#pragma unroll
                for (int e = 0; e < 8; ++e) { g2[e] = sp[j0 + e]; v2[e] = sp[DFF + j0 + e]; g1[e] = sp[NUP + j0 + e]; v1[e] = sp[NUP + DFF + j0 + e]; } }
            else {
#pragma unroll
                for (int e = 0; e < 8; ++e) { g2[e] = v2[e] = g1[e] = v1[e] = 0.f; } }
        } else {
            const v4u a2 = *(const GAS v4u*)(up + (size_t)(m0 - 2) * NUP + j0), b2 = *(const GAS v4u*)(up + (size_t)(m0 - 2) * NUP + DFF + j0);
            const v4u a1 = *(const GAS v4u*)(up + (size_t)(m0 - 1) * NUP + j0), b1 = *(const GAS v4u*)(up + (size_t)(m0 - 1) * NUP + DFF + j0);
            g2[0] = bf_lo(a2.x); g2[1] = bf_hi(a2.x); g2[2] = bf_lo(a2.y); g2[3] = bf_hi(a2.y); g2[4] = bf_lo(a2.z); g2[5] = bf_hi(a2.z); g2[6] = bf_lo(a2.w); g2[7] = bf_hi(a2.w);
            v2[0] = bf_lo(b2.x); v2[1] = bf_hi(b2.x); v2[2] = bf_lo(b2.y); v2[3] = bf_hi(b2.y); v2[4] = bf_lo(b2.z); v2[5] = bf_hi(b2.z); v2[6] = bf_lo(b2.w); v2[7] = bf_hi(b2.w);
            g1[0] = bf_lo(a1.x); g1[1] = bf_hi(a1.x); g1[2] = bf_lo(a1.y); g1[3] = bf_hi(a1.y); g1[4] = bf_lo(a1.z); g1[5] = bf_hi(a1.z); g1[6] = bf_lo(a1.w); g1[7] = bf_hi(a1.w);
            v1[0] = bf_lo(b1.x); v1[1] = bf_hi(b1.x); v1[2] = bf_lo(b1.y); v1[3] = bf_hi(b1.y); v1[4] = bf_lo(b1.z); v1[5] = bf_hi(b1.z); v1[6] = bf_lo(b1.w); v1[7] = bf_hi(b1.w);
        }
#pragma unroll 2
        for (int rr = 0; rr < 16; ++rr) {
            const size_t m = (size_t)(m0 + rr);
            const v4u a0 = *(const GAS v4u*)(up + m * NUP + j0), b0 = *(const GAS v4u*)(up + m * NUP + DFF + j0);
            float g0[8], v0[8];
            g0[0] = bf_lo(a0.x); g0[1] = bf_hi(a0.x); g0[2] = bf_lo(a0.y); g0[3] = bf_hi(a0.y); g0[4] = bf_lo(a0.z); g0[5] = bf_hi(a0.z); g0[6] = bf_lo(a0.w); g0[7] = bf_hi(a0.w);
            v0[0] = bf_lo(b0.x); v0[1] = bf_hi(b0.x); v0[2] = bf_lo(b0.y); v0[3] = bf_hi(b0.y); v0[4] = bf_lo(b0.z); v0[5] = bf_hi(b0.z); v0[6] = bf_lo(b0.w); v0[7] = bf_hi(b0.w);
            float res[8];
#pragma unroll
            for (int e = 0; e < 8; e += 2) {
                f32x2 cg, cv;
                cg.x = bg[e] + wg[0][e] * g2[e] + wg[1][e] * g1[e] + wg[2][e] * g0[e]; cg.y = bg[e + 1] + wg[0][e + 1] * g2[e + 1] + wg[1][e + 1] * g1[e + 1] + wg[2][e + 1] * g0[e + 1];
                cv.x = bv[e] + wv[0][e] * v2[e] + wv[1][e] * v1[e] + wv[2][e] * v0[e]; cv.y = bv[e + 1] + wv[0][e + 1] * v2[e + 1] + wv[1][e + 1] * v1[e + 1] + wv[2][e + 1] * v0[e + 1];
                const f32x2 ge = pg8::gelu_pk(cg);
                res[e] = ge.x * cv.x; res[e + 1] = ge.y * cv.y;
            }
            v4u w; w.x = pk2(res[0], res[1]); w.y = pk2(res[2], res[3]); w.z = pk2(res[4], res[5]); w.w = pk2(res[6], res[7]);
            *(GAS v4u*)(act + m * DFF + j0) = w;
#pragma unroll
            for (int e = 0; e < 8; ++e) { g2[e] = g1[e]; g1[e] = g0[e]; v2[e] = v1[e]; v1[e] = v0[e]; }
        }
    }
}

constexpr int N_PHASES = 13;
struct Args { const float* in[31]; float* out; unsigned char* ws; int ph_lo, ph_hi; };
__global__ void __launch_bounds__(NWAVES * 64, 2) mk_fwd(Args args) {
    extern __shared__ __attribute__((aligned(16))) unsigned char lds[];
    Frame F;
    F.lds = (LAS unsigned char*)lds;
    F.MISC = (volatile LAS unsigned*)(F.lds + MISC_OFF);
    F.wave = __builtin_amdgcn_readfirstlane((int)threadIdx.x >> 6);
    F.G = gridDim.x; { const int bx = blockIdx.x; F.vcu = (F.G % 8 == 0) ? (bx % 8) * (F.G / 8) + bx / 8 : bx; }
    F.out = args.out; F.ws = args.ws;
    F.ctl = (gu32*)(args.ws + WS_CTL);
    for (int u = ((int)threadIdx.x); u < (LDS_BYTES - LDSCTL_OFF) / 4; u += NWAVES * 64) ((LAS unsigned*)(F.lds + LDSCTL_OFF))[u] = 0u;
    __syncthreads();
    const int lo = args.ph_lo, hi = args.ph_hi;
    XcdBarrier bar; bar.bar = (unsigned*)(F.ctl + CW_BAR); bar.x = 0; bar.st = nullptr;
    if (hi - lo > 1) bar = xcd_barrier_post((unsigned*)(F.ctl + CW_BAR), F.MISC + 8);
#ifndef PH_MASK
#define PH_MASK 0xFFFFu
#endif
#define IN(k) (((PH_MASK >> (k)) & 1u) && lo <= (k) && (k) < hi)
#define SEAM(k) do { if (IN(k) && IN((k) + 1)) xcd_barrier(bar); } while (0)
    typedef pg8::StaticOrder SO;
    const int bx = (int)blockIdx.x;
    if (IN(0)) { REP(0) phase_p0(F); SEAM(0); }
    if (IN(1)) {
        pg8::Gemm g{(const bf16*)(F.ws + WS_H0B), (const bf16*)(F.ws + WS_BT1), NTOK, N1, DM, DM, DM}; SO S; S.init(NTOK, N1, F.G, bx);
        EpiIn E{(bf16*)(F.ws + WS_MIX), (bf16*)(F.ws + WS_KB), (bf16*)(F.ws + WS_VT), (bf16*)(F.ws + WS_PRW), (const float*)(F.ws + WS_ROPE), F.out};
        REP(1) pg8::gemm_phase<EpiIn, SO, true, true>(F.lds, g, S, E);
        SEAM(1);
    }
    if (IN(2)) { REP(2) phase_prep_a(F); SEAM(2); }
    if (IN(3)) REP(3) {
        const bf16* al = (const bf16*)(F.ws + WS_ALORA);
        { pg8::Gemm g{al, (const bf16*)(F.ws + WS_BTD), NTOK, 1024, 128, 512, 128}; SO S; S.init(NTOK, 1024, F.G, bx, 128);
          EpiDecay E{(float*)(F.ws + WS_REC), inptr(12)}; pg8::gemm_phase<EpiDecay, SO, true, true>(F.lds, g, S, E); }
        { pg8::Gemm g{al + 128, (const bf16*)(F.ws + WS_BTA), NTOK, 1024, 128, 512, 128}; SO S; S.init(NTOK, 1024, F.G, (bx + 132) % F.G, 128);
          EpiVec<0> E{(bf16*)(F.ws + WS_ASIG), inptr(14)}; pg8::gemm_phase<EpiVec<0>, SO, true, true>(F.lds, g, S, E); }
        { pg8::Gemm g{al + 256, (const bf16*)(F.ws + WS_BTG), NTOK, 1024, 256, 512, 256}; SO S; S.init(NTOK, 1024, F.G, (bx + 8) % F.G, 256);
          EpiVec<1> E{(bf16*)(F.ws + WS_G), nullptr}; pg8::gemm_phase<EpiVec<1>, SO, true, true>(F.lds, g, S, E); }
    }
    SEAM(3);
    if (IN(4)) { REP(4) phase_prep_b(F); SEAM(4); }
    if (IN(5)) { phase_scan(F); SEAM(5); }
    if (IN(6)) { REP(6) phase_post(F); SEAM(6); }
    if (IN(7)) {
        pg8::Gemm g{(const bf16*)(F.ws + WS_MIX), (const bf16*)(F.ws + WS_BT2), NTOK, DM, DM, DM, DM}; { SO S; S.init(NPROMPT, DM, F.G, bx, DM); EpiRes E{F.out + O_Y}; pg8::gemm_phase<EpiRes, SO, true, true>(F.lds, g, S, E); }
        { pg8::SubOrder S; S.init(32, DM, DM, 8, F.G, bx); EpiSlab E{(float*)(F.ws + WS_SLAB)}; pg8::gemm_phase<EpiSlab, pg8::SubOrder, true, true>(F.lds, g, S, E); }
        SEAM(7);
    }
    if (IN(8)) { phase_ln<true>(F, inptr(23), inptr(24), (bf16*)(F.ws + WS_H1B), 8); SEAM(8); }
    if (IN(9)) {
        pg8::Gemm g{(const bf16*)(F.ws + WS_H1B), (const bf16*)(F.ws + WS_BT3), NTOK, NUP, DM, DM, DM}; SO S; S.init(NTOK, NUP, F.G, bx);
        EpiUp E{(bf16*)(F.ws + WS_UP), F.out}; REP(9) pg8::gemm_phase<EpiUp, SO, true, true>(F.lds, g, S, E);
        SEAM(9);
    }
    if (IN(10)) { REP(10) phase_conv(F); SEAM(10); }
    if (IN(11)) {
        pg8::Gemm g{(const bf16*)(F.ws + WS_ACT), (const bf16*)(F.ws + WS_BT4), NTOK, DM, DFF, DFF, DFF}; { SO S; S.init(NPROMPT, DM, F.G, bx, DFF); EpiRes E{F.out + O_Y}; pg8::gemm_phase<EpiRes, SO, true, true>(F.lds, g, S, E); }
        { pg8::SubOrder S; S.init(32, DM, DFF, 11, F.G, bx); EpiSlab E{(float*)(F.ws + WS_SLAB)}; pg8::gemm_phase<EpiSlab, pg8::SubOrder, true, true>(F.lds, g, S, E); }
        SEAM(11);
    }
    if (IN(12)) { phase_ln<false>(F, inptr(29), inptr(30), nullptr, 11); }
#undef IN
#undef SEAM
}

extern "C" void kernel_launch(void* const* d_in, const int* in_sizes, int n_in, void* d_out, int out_size, void* d_ws, size_t ws_size, hipStream_t stream) {
    static int grid = 0;
    if (grid == 0) {
        if (n_in != 31 || ws_size < WS_END) { fprintf(stderr, "kernel_launch: unexpected inputs (n_in %d, ws %zu)\n", n_in, ws_size); grid = -1; return; }
        int dev = 0, cus = 0, per_cu = 0;
        if (hipGetDevice(&dev) != hipSuccess || hipDeviceGetAttribute(&cus, hipDeviceAttributeMultiprocessorCount, dev) != hipSuccess) { grid = -1; return; }
        if (hipFuncSetAttribute((const void*)mk_fwd, hipFuncAttributeMaxDynamicSharedMemorySize, LDS_BYTES) != hipSuccess) { fprintf(stderr, "kernel_launch: hipFuncSetAttribute failed\n"); grid = -1; return; }
        if (hipOccupancyMaxActiveBlocksPerMultiprocessor(&per_cu, (const void*)mk_fwd, NWAVES * 64, LDS_BYTES) != hipSuccess || per_cu < 1) { fprintf(stderr, "kernel_launch: occupancy query says %d\n", per_cu); per_cu = 1; }
        (void)hipGetLastError();
        grid = cus;
    }
    if (grid < 0) return;
    (void)hipMemsetAsync((char*)d_ws + WS_CTL, 0, CTL_ZERO_BYTES, stream);
    Args a{};
    for (int i = 0; i < 31; ++i) a.in[i] = (const float*)d_in[i];
    a.out = (float*)d_out; a.ws = (unsigned char*)d_ws;
#if MK_PER_PHASE
    for (int p = 0; p < N_PHASES; ++p) { a.ph_lo = p; a.ph_hi = p + 1; hipLaunchKernelGGL(mk_fwd, dim3(grid), dim3(NWAVES * 64), LDS_BYTES, stream, a); }
#else
    a.ph_lo = 0; a.ph_hi = N_PHASES;
    hipLaunchKernelGGL(mk_fwd, dim3(grid), dim3(NWAVES * 64), LDS_BYTES, stream, a);
#endif
}
```

```cpp
#include <hip/hip_runtime.h>
#include <cstdio>
#include <cstdint>

#ifndef DUP_K
#define DUP_K -1
#endif
#ifndef DUP_MASK
#define DUP_MASK 0u
#endif
#define REP(k) for (int rep_ = 0; rep_ < ((DUP_K == (k) || ((DUP_MASK >> (k)) & 1u)) ? 2 : 1); ++rep_)
#ifndef MK_PER_PHASE
#define MK_PER_PHASE 0
#endif

namespace pg8 {
#define PG8_LAS __attribute__((address_space(3)))
typedef unsigned short bf16_t;
typedef short bf16x8 __attribute__((ext_vector_type(8)));
typedef float f32x4 __attribute__((ext_vector_type(4)));
typedef unsigned u32x4 __attribute__((ext_vector_type(4)));
constexpr int BM = 256, BK = 64, HALF = 128, HTB = HALF * BK * 2, STAGE_BYTES = 8 * HTB, NXCD = 8, WGM = 8;

__host__ __device__ __forceinline__ int lds_byte(int r, int c) { const int st = (r >> 4) * 2 + (c >> 5), rr = r & 15, cc = c & 31, ob = rr * 64 + cc * 2; return st * 1024 + (ob ^ (((ob >> 9) & 1) << 5)); }
__host__ __device__ __forceinline__ void stage_rc(int b, int& R, int& C) { const int st = b / 1024, sb = b % 1024, swz = sb ^ (((sb >> 9) & 1) << 5); R = (st >> 1) * 16 + swz / 64; C = (st & 1) * 32 + (swz % 64) / 2; }
__host__ __device__ __forceinline__ int perm32(int rho) { const int n = rho >> 4, i = rho & 15; return 8 * (i >> 2) + 4 * n + (i & 3); }

struct Unit { int pm, pn, kt0, nt, ks; };
struct Gemm { const bf16_t* A; const bf16_t* Bt; int M, N, K, lda, ldb; };

struct StaticOrder {
    int nM, nN, nwg, G, c, ntf;
    __host__ __device__ void init(int M, int N, int G_, int c_, int K_ = 2048) { nM = M / BM; nN = N / BM; nwg = nM * nN; G = G_; c = c_; ntf = K_ / BK; }
    __host__ __device__ bool next(int i, Unit& u) const {
        u.kt0 = 0; u.nt = ntf; u.ks = 0;
        const long L = (long)i * G + c; if (L >= nwg) return false;
        int wgid = (int)L; { const int q = nwg / NXCD, r = nwg % NXCD, xcd = wgid % NXCD, off = wgid / NXCD; wgid = (xcd < r ? xcd * (q + 1) : r * (q + 1) + (xcd - r) * q) + off; }
        const int nig = WGM * nN, gid = wgid / nig, fm = gid * WGM, gsz = (nM - fm) < WGM ? (nM - fm) : WGM;
        u.pm = fm + ((wgid % nig) % gsz); u.pn = (wgid % nig) / gsz; return true;
    }
};

struct SubOrder {
    int pm, nN, S, ntp, G, c;
    __host__ __device__ void init(int pm_, int N, int K, int S_, int G_, int c_) { pm = pm_; nN = N / BM; S = S_; ntp = K / BK / S_; G = G_; c = c_; }
    __host__ __device__ bool next(int i, Unit& u) const {
        const long j = (long)i * G + c; if (j >= nN * S) return false;
        u.pm = pm; u.pn = (int)j % nN; u.ks = (int)j / nN; u.kt0 = u.ks * ntp; u.nt = ntp; return true;
    }
};
__device__ __forceinline__ unsigned cvt_pk_bf16(float lo, float hi) { unsigned r; asm volatile("v_cvt_pk_bf16_f32 %0, %1, %2" : "=v"(r) : "v"(lo), "v"(hi)); return r; }
typedef float f32x2 __attribute__((ext_vector_type(2)));
__device__ __forceinline__ f32x2 gelu_pk(f32x2 v) {
    const f32x2 av = __builtin_elementwise_abs(v), d = av * 0.2316418882f + 1.0f;
    f32x2 t; t.x = __builtin_amdgcn_rcpf(d.x); t.y = __builtin_amdgcn_rcpf(d.y);
    f32x2 q = t * 0.5307027145f + (-0.7265760135f); q = q * t + 0.7107068705f; q = q * t + (-0.142248368f); q = q * t + 0.127414796f; q = q * t;
    const f32x2 s = (v * v) * (-0.72134752044f);
    f32x2 e; e.x = __builtin_amdgcn_exp2f(s.x); e.y = __builtin_amdgcn_exp2f(s.y);
    const f32x2 m = v * (q * e), r = v - m;
    f32x2 o; o.x = v.x < 0.f ? m.x : r.x; o.y = v.y < 0.f ? m.y : r.y; return o;
}

template <class Epi, class Sched, bool ALIGN_EPI = false, bool SP2 = false>
__device__ __forceinline__ void gemm_phase(PG8_LAS unsigned char* lds, const Gemm g, const Sched& S, const Epi& E) {
    int tid_ = threadIdx.x; asm volatile("" : "+v"(tid_));
    const int tid = tid_, wid = __builtin_amdgcn_readfirstlane(tid >> 6), lane = tid & 63, wr = wid >> 2, wc = wid & 3, fr = lane & 15, fq = lane >> 4;
    unsigned voffA[2], voffB[2];
#pragma unroll
    for (int i = 0; i < 2; ++i) { int R, C; stage_rc(tid * 16 + i * 8192, R, C); const int Rb = Epi::PERM ? ((R & ~31) + perm32(R & 31)) : R;
        voffA[i] = (unsigned)(R * g.lda + C) * 2u; voffB[i] = (unsigned)(Rb * g.ldb + C) * 2u; }
    const size_t kstep = (size_t)(BK * 2);
    const size_t hstepA = (size_t)HALF * g.lda * 2, hstepB = (size_t)HALF * g.ldb * 2;
    const size_t tstepA = 2 * hstepA, tstepB = 2 * hstepB;
    const unsigned ldsw = (unsigned)wid * 1024u;
    const int aoff = lds_byte(wr * 64 + fr, fq * 8), boff = lds_byte(wc * 32 + fr, fq * 8);
#define PG8_SA(b, h) (((b) * 2 + (h)) * HTB)
#define PG8_SB(b, h) ((4 + (b) * 2 + (h)) * HTB)
#define PG8_STAGE(bufoff, gbase, voff) do { _Pragma("unroll") for (int _i = 0; _i < 2; ++_i) \
        __builtin_amdgcn_global_load_lds((const unsigned*)((const char*)(gbase) + (voff)[_i]), (PG8_LAS unsigned*)(lds + (bufoff) + ldsw + _i * 8192), 16, 0, 0); } while (0)
#define PG8_LDA(dst, b, h) do { _Pragma("unroll") for (int m = 0; m < 4; ++m) _Pragma("unroll") for (int k = 0; k < 2; ++k) dst[m][k] = *(const PG8_LAS bf16x8*)(lds + PG8_SA(b, h) + aoff + m * 2048 + k * 1024); } while (0)
#define PG8_LDB(dst, b, h) do { _Pragma("unroll") for (int n = 0; n < 2; ++n) _Pragma("unroll") for (int k = 0; k < 2; ++k) dst[n][k] = *(const PG8_LAS bf16x8*)(lds + PG8_SB(b, h) + boff + n * 2048 + k * 1024); } while (0)
#define PG8_MMA(ai, bj, At, Bt) do { __builtin_amdgcn_s_setprio(1); _Pragma("unroll") for (int m = 0; m < 4; ++m) _Pragma("unroll") for (int n = 0; n < 2; ++n) _Pragma("unroll") for (int k = 0; k < 2; ++k) \
        acc[ai][bj][m][n] = __builtin_amdgcn_mfma_f32_16x16x32_bf16(Bt[n][k], At[m][k], acc[ai][bj][m][n], 0, 0, 0); __builtin_amdgcn_s_setprio(0); } while (0)
#define PG8_WAIT_V(n) asm volatile("s_waitcnt vmcnt(" #n ")" ::: "memory")
#define PG8_WAIT_L(n) asm volatile("s_waitcnt lgkmcnt(" #n ")" ::: "memory")
#define PG8_BAR __builtin_amdgcn_s_barrier()
#define PG8_SCHED __builtin_amdgcn_sched_barrier(0)
    Unit cur, nxt; int ui = 0;
    if (!S.next(0, cur)) return;
    f32x4 acc[2][2][4][2];
#pragma unroll
    for (int a = 0; a < 2; ++a)
#pragma unroll
        for (int b = 0; b < 2; ++b)
#pragma unroll
            for (int m = 0; m < 4; ++m)
#pragma unroll
                for (int n = 0; n < 2; ++n) acc[a][b][m][n] = (f32x4){0.f, 0.f, 0.f, 0.f};
    bf16x8 At[4][2], B0[2][2], B1[2][2];
    int nt = cur.nt;
    const char* cA = (const char*)g.A + (size_t)cur.pm * tstepA + (size_t)cur.kt0 * kstep; const char* cB = (const char*)g.Bt + (size_t)cur.pn * tstepB + (size_t)cur.kt0 * kstep;
    if constexpr (SP2) {
        PG8_STAGE(PG8_SB(0, 0), cB, voffB); PG8_STAGE(PG8_SB(0, 1), cB + hstepB, voffB); PG8_STAGE(PG8_SA(0, 0), cA, voffA); PG8_STAGE(PG8_SA(0, 1), cA + hstepA, voffA);
        if (wr == 1) PG8_BAR;
        PG8_WAIT_V(2); PG8_BAR;
        PG8_STAGE(PG8_SB(1, 0), cB + kstep, voffB); PG8_STAGE(PG8_SA(1, 0), cA + kstep, voffA); PG8_STAGE(PG8_SB(1, 1), cB + hstepB + kstep, voffB);
        PG8_WAIT_V(6); PG8_BAR;
    } else {
        PG8_STAGE(PG8_SB(0, 0), cB, voffB); PG8_STAGE(PG8_SA(0, 0), cA, voffA); PG8_STAGE(PG8_SB(0, 1), cB + hstepB, voffB); PG8_STAGE(PG8_SA(0, 1), cA + hstepA, voffA);
        if (wr == 1) PG8_BAR;
        PG8_WAIT_V(4); PG8_BAR;
        PG8_STAGE(PG8_SB(1, 0), cB + kstep, voffB); PG8_STAGE(PG8_SA(1, 0), cA + kstep, voffA); PG8_STAGE(PG8_SB(1, 1), cB + hstepB + kstep, voffB);
        PG8_WAIT_V(6); PG8_BAR;
    }
    for (;;) {
        const bool has_next = S.next(ui + 1, nxt);
        const char* nA = has_next ? (const char*)g.A + (size_t)nxt.pm * tstepA + (size_t)nxt.kt0 * kstep : cA; const char* nB = has_next ? (const char*)g.Bt + (size_t)nxt.pn * tstepB + (size_t)nxt.kt0 * kstep : cB;
        for (int t = 0; t < nt; t += 2) {
            const bool last = (t == nt - 2);
            const char* a1 = cA + (size_t)(t + 1) * kstep;
            const char* a2 = last ? nA : cA + (size_t)(t + 2) * kstep; const char* b2 = last ? nB : cB + (size_t)(t + 2) * kstep;
            const char* a3 = a2 + kstep; const char* b3 = b2 + kstep;
            if constexpr (SP2) {
            PG8_LDB(B0, 0, 0); PG8_LDB(B1, 0, 1); PG8_SCHED; PG8_LDA(At, 0, 0); PG8_STAGE(PG8_SA(1, 1), a1 + hstepA, voffA);
            PG8_WAIT_V(8); PG8_WAIT_L(0); PG8_BAR; PG8_MMA(0, 0, At, B0); PG8_MMA(0, 1, At, B1); PG8_BAR; PG8_SCHED;
            PG8_LDA(At, 0, 1); PG8_STAGE(PG8_SB(0, 0), b2, voffB); PG8_STAGE(PG8_SB(0, 1), b2 + hstepB, voffB); PG8_STAGE(PG8_SA(0, 0), a2, voffA);
            PG8_WAIT_V(8); PG8_WAIT_L(0); PG8_BAR; PG8_MMA(1, 0, At, B0); PG8_MMA(1, 1, At, B1); PG8_BAR; PG8_SCHED;
            PG8_LDB(B0, 1, 0); PG8_LDB(B1, 1, 1); PG8_SCHED; PG8_LDA(At, 1, 0); PG8_STAGE(PG8_SA(0, 1), a2 + hstepA, voffA);
            PG8_WAIT_V(8); PG8_WAIT_L(0); PG8_BAR; PG8_MMA(0, 0, At, B0); PG8_MMA(0, 1, At, B1); PG8_BAR; PG8_SCHED;
            PG8_LDA(At, 1, 1); PG8_STAGE(PG8_SB(1, 0), b3, voffB); PG8_STAGE(PG8_SB(1, 1), b3 + hstepB, voffB); PG8_STAGE(PG8_SA(1, 0), a3, voffA);
            PG8_WAIT_V(8); PG8_WAIT_L(0); PG8_BAR; PG8_MMA(1, 0, At, B0); PG8_MMA(1, 1, At, B1); PG8_BAR; PG8_SCHED;
            } else {
            PG8_LDB(B0, 0, 0); PG8_SCHED; PG8_LDA(At, 0, 0); PG8_STAGE(PG8_SA(1, 1), a1 + hstepA, voffA);
            PG8_WAIT_L(8); PG8_BAR; PG8_WAIT_L(0); PG8_MMA(0, 0, At, B0); PG8_BAR; PG8_SCHED;
            PG8_LDB(B1, 0, 1); PG8_STAGE(PG8_SB(0, 0), b2, voffB);
            PG8_BAR; PG8_WAIT_L(0); PG8_MMA(0, 1, At, B1); PG8_BAR;
            PG8_LDA(At, 0, 1); PG8_STAGE(PG8_SA(0, 0), a2, voffA);
            PG8_BAR; PG8_WAIT_L(0); PG8_MMA(1, 0, At, B0); PG8_BAR; PG8_SCHED;
            PG8_STAGE(PG8_SB(0, 1), b2 + hstepB, voffB);
            PG8_WAIT_V(6); PG8_BAR; PG8_MMA(1, 1, At, B1); PG8_BAR;
            PG8_LDB(B0, 1, 0); PG8_SCHED; PG8_LDA(At, 1, 0); PG8_STAGE(PG8_SA(0, 1), a2 + hstepA, voffA);
            PG8_WAIT_L(8); PG8_BAR; PG8_WAIT_L(0); PG8_MMA(0, 0, At, B0); PG8_BAR; PG8_SCHED;
            PG8_LDB(B1, 1, 1); PG8_STAGE(PG8_SB(1, 0), b3, voffB);
            PG8_BAR; PG8_WAIT_L(0); PG8_MMA(0, 1, At, B1); PG8_BAR;
            PG8_LDA(At, 1, 1); PG8_STAGE(PG8_SA(1, 0), a3, voffA);
            PG8_BAR; PG8_WAIT_L(0); PG8_MMA(1, 0, At, B0); PG8_BAR; PG8_SCHED;
            PG8_STAGE(PG8_SB(1, 1), b3 + hstepB, voffB);
            PG8_WAIT_V(6); PG8_BAR; PG8_MMA(1, 1, At, B1); PG8_BAR;
            }
        }
        if constexpr (ALIGN_EPI) { if (wr == 0) PG8_BAR; }
        E(acc, cur, wr, wc, fr, fq);
        if (!has_next) break;
#pragma unroll
        for (int a = 0; a < 2; ++a)
#pragma unroll
            for (int b = 0; b < 2; ++b)
#pragma unroll
                for (int m = 0; m < 4; ++m)
#pragma unroll
                    for (int n = 0; n < 2; ++n) acc[a][b][m][n] = (f32x4){0.f, 0.f, 0.f, 0.f};
        cur = nxt; cA = nA; cB = nB; nt = cur.nt; ++ui;
        if constexpr (ALIGN_EPI) { if (wr == 1) PG8_BAR; }
    }
    PG8_WAIT_V(0);
    if constexpr (!ALIGN_EPI) { if (wr == 0) PG8_BAR; }
    PG8_BAR;
#undef PG8_SA
#undef PG8_SB
#undef PG8_STAGE
#undef PG8_LDA
#undef PG8_LDB
#undef PG8_MMA
#undef PG8_WAIT_V
#undef PG8_WAIT_L
#undef PG8_BAR
#undef PG8_SCHED
}
}

constexpr int NWAVES = 8;
constexpr int DM = 2048, NTOK = 8448, NPROMPT = 8192;
constexpr int INC = 4640, N1 = 4864, RWC = 3360, PRW_LD = 3584, DFF = 5632, NUP = 11264;
constexpr float LN_EPS = 1e-5f, LNX_EPS = 64e-5f;
constexpr float ALPHA = 1.189207115002721f;
constexpr int RC_R = 0, RC_WD = 1024, RC_K = 1088, RC_V = 2112, RC_AD = 3136, RC_GD = 3200;
constexpr size_t O_Y = 0, O_PK = 17301504, O_PV = 17367040, O_PWKV = 17432576, O_PSHIFT = 17694720, O_PCONV = 17708160,
                 O_SK = 17798272, O_SV = 17929344, O_SWKV = 18060416, O_SSHIFT = 18584704, O_SCONV = 18611584;
constexpr size_t MiB = 1u << 20;
constexpr size_t QMiB = 1u << 18;
constexpr size_t WS_CTL = 0, CTL_ZERO_BYTES = 1 * MiB;
constexpr size_t WS_BT1 = 1 * MiB;
constexpr size_t WS_BT4 = 1 * MiB;
constexpr size_t WS_H0B = 23 * MiB;
constexpr size_t WS_REC = 23 * MiB;
constexpr size_t WS_G   = 188 * MiB;
constexpr size_t WS_SLAB = 23 * MiB;
constexpr size_t WS_UP  = 23 * MiB;
constexpr size_t WS_PRW = 818 * QMiB;
constexpr size_t WS_BT3 = 818 * QMiB;
constexpr size_t WS_O   = 994 * QMiB;
constexpr size_t WS_H1B = 994 * QMiB;
constexpr size_t WS_ALORA = 1049 * QMiB;
constexpr size_t WS_ASIG = 1082 * QMiB;
constexpr size_t WS_VCOPY = 287 * MiB;
constexpr size_t WS_ACT = 818 * QMiB;
constexpr size_t WS_BT2 = 1218 * QMiB;
constexpr size_t WS_MIX = 1250 * QMiB;
constexpr size_t WS_KB  = 1382 * QMiB;
constexpr size_t WS_VB  = WS_KB + (size_t)NTOK * 128 * 2;
constexpr size_t WS_ROPE = WS_VB + (size_t)NTOK * 128 * 2;
constexpr size_t WS_RKR = WS_ROPE + 2048 * 64 * 4;
constexpr size_t WS_BTD = WS_RKR + (size_t)NTOK * 16 * 4;
constexpr size_t WS_BTA = WS_BTD + 1024 * 128 * 2;
constexpr size_t WS_BTG = WS_BTA + 1024 * 128 * 2;
constexpr size_t WS_END = WS_BTG + 1024 * 256 * 2;
static_assert(WS_END <= 352 * MiB, "ws map");
static_assert(WS_ALORA >= WS_PRW + (size_t)NTOK * PRW_LD * 2, "alora after prw");
static_assert(WS_ACT + (size_t)NTOK * DFF * 2 <= WS_BT2, "act below bt2");
static_assert(WS_VCOPY + (size_t)NTOK * 1024 * 2 <= WS_BT2, "vcopy below bt2");
static_assert(WS_REC + (size_t)NTOK * 16 * 320 * 4 <= WS_G, "rec below g");
static_assert(WS_UP + (size_t)NTOK * NUP * 2 <= WS_BT3, "up below bt3");
constexpr int CW_BAR = 4096;

constexpr int RING_BYTES = 131072;
constexpr int LDSCTL_OFF = RING_BYTES, MISC_OFF = LDSCTL_OFF + 320;
constexpr int LDS_BYTES = 147456;

#define GAS __attribute__((address_space(1)))
#define LAS __attribute__((address_space(3)))
typedef unsigned short bf16;
typedef unsigned v4u __attribute__((ext_vector_type(4)));
typedef unsigned v2u __attribute__((ext_vector_type(2)));
typedef float f32x4 __attribute__((ext_vector_type(4)));
typedef float f32x2 __attribute__((ext_vector_type(2)));
typedef float f32x16 __attribute__((ext_vector_type(16)));
typedef short bf16x8 __attribute__((ext_vector_type(8)));
typedef short s16x4 __attribute__((ext_vector_type(4)));
typedef GAS unsigned gu32;
#define RLX_AGENT __ATOMIC_RELAXED, __HIP_MEMORY_SCOPE_AGENT
#define LDS_WAIT() asm volatile("s_waitcnt lgkmcnt(0)" ::: "memory")
#define VM_WAIT() asm volatile("s_waitcnt vmcnt(0)" ::: "memory")
__device__ __forceinline__ unsigned f2bf(float f) { unsigned u = __builtin_bit_cast(unsigned, f); return (u + 0x7fffu + ((u >> 16) & 1u)) >> 16; }
__device__ __forceinline__ unsigned pk2(float lo, float hi) { return f2bf(lo) | (f2bf(hi) << 16); }
__device__ __forceinline__ float bf_lo(unsigned w) { return __builtin_bit_cast(float, w << 16); }
__device__ __forceinline__ float bf_hi(unsigned w) { return __builtin_bit_cast(float, w & 0xffff0000u); }

#define XB_TMO      128
#define XB_XCNT(j)  (256  + 64 * (j))
#define XB_XSUB(j)  (1280 + 64 * (j))
#define XB_XGEN(j)  (2304 + 64 * (j))
#define XB_TOP      3328
#define XB_TOPGEN   3392
#define XCD_BAR_WORDS 3456
#define XB_SPIN_CAP (1u << 18)
__device__ __forceinline__ unsigned xb_ld(unsigned* p)              { return __hip_atomic_load(p, __ATOMIC_RELAXED, __HIP_MEMORY_SCOPE_AGENT); }
__device__ __forceinline__ unsigned xb_add(unsigned* p, unsigned v) { return __hip_atomic_fetch_add(p, v, __ATOMIC_RELAXED, __HIP_MEMORY_SCOPE_AGENT); }
__device__ __forceinline__ unsigned xb_xcc_id() { return (unsigned)__builtin_amdgcn_s_getreg((3 << 11) | 20) & 0xFu; }
#define XB_SPIN(cond, bar) do { unsigned _sp = 0; while (cond) { __builtin_amdgcn_s_sleep(1); \
    if ((++_sp & 255u) == 0u) { if (xb_ld(&(bar)[XB_TMO])) break; if (_sp > XB_SPIN_CAP) { atomicAdd(&(bar)[XB_TMO], 1u); break; } } } } while (0)
struct XcdBarrier { unsigned* bar; unsigned x; volatile LAS unsigned* st; };
__device__ __forceinline__ XcdBarrier xcd_barrier_post(unsigned* bar, volatile LAS unsigned* st) {
    XcdBarrier b; b.bar = bar; b.x = xb_xcc_id(); b.st = st;
    if (threadIdx.x == 0) (void)xb_add(&bar[XB_XCNT(b.x)], 1u);
    return b;
}
__device__ __forceinline__ void xcd_barrier_complete(unsigned* bar, unsigned x, unsigned& nloc, unsigned& nx) {
    const unsigned G = gridDim.x * gridDim.y * gridDim.z;
    unsigned sum, cnt, mine, sp = 0u;
    for (;;) {
        sum = 0u; cnt = 0u; mine = 0u;
#pragma unroll
        for (unsigned j = 0; j < 16; ++j) { const unsigned c = xb_ld(&bar[XB_XCNT(j)]); sum += c; cnt += (c > 0u) ? 1u : 0u; mine = (j == x) ? c : mine; }
        if (sum == G) break;
        __builtin_amdgcn_s_sleep(1);
        if ((++sp & 255u) == 0u) { if (xb_ld(&bar[XB_TMO])) break; if (sp > XB_SPIN_CAP) { atomicAdd(&bar[XB_TMO], 1u); break; } }
    }
    nloc = mine > 0u ? mine : 1u; nx = cnt > 0u ? cnt : 1u;
}
__device__ __forceinline__ void xcd_barrier(const XcdBarrier& b) {
    asm volatile("s_waitcnt vmcnt(0)" ::: "memory");
    __syncthreads();
    if (threadIdx.x == 0) {
        unsigned* bar = b.bar;
        __builtin_amdgcn_s_waitcnt(0);
        unsigned nloc = b.st[0], nx = b.st[1];
        if (nloc == 0u) { xcd_barrier_complete(bar, b.x, nloc, nx); b.st[0] = nloc; b.st[1] = nx; }
        const unsigned old = xb_add(&bar[XB_XSUB(b.x)], 1u);
        const unsigned gen = old / nloc;
        if (old + 1u == (gen + 1u) * nloc) {
            __builtin_amdgcn_fence(__ATOMIC_RELEASE, "agent");
            asm volatile("s_waitcnt vmcnt(0)" ::: "memory");
            const unsigned og = xb_add(&bar[XB_TOP], 1u);
            const unsigned tg = og / nx;
            if (og + 1u == (tg + 1u) * nx) xb_add(&bar[XB_TOPGEN], 1u);
            else XB_SPIN(xb_ld(&bar[XB_TOPGEN]) == tg, bar);
            __builtin_amdgcn_fence(__ATOMIC_ACQUIRE, "agent");
            xb_add(&bar[XB_XGEN(b.x)], 1u);
            asm volatile("s_waitcnt vmcnt(0)" ::: "memory");
        } else {
            XB_SPIN(xb_ld(&bar[XB_XGEN(b.x)]) == gen, bar);
            __builtin_amdgcn_fence(__ATOMIC_ACQUIRE, "agent");
            asm volatile("s_waitcnt vmcnt(0)" ::: "memory");
        }
    }
    __syncthreads();
}

struct RowInfo { int seq, t, L, pos; };
__device__ __forceinline__ RowInfo rowinfo(int m) {
    RowInfo r;
    if (m < NPROMPT) { r.seq = m >> 11; r.t = m & 2047; r.L = 2048; r.pos = r.t; }
    else { const int q = m - NPROMPT; r.seq = 4 + (q >> 5); r.t = q & 31; r.L = 32; r.pos = 1024 + r.t; }
    return r;
}
__device__ __forceinline__ float wave_sum(float v) {
#pragma unroll
    for (int o = 1; o < 64; o <<= 1) v += __shfl_xor(v, o);
    return v;
}
template <int CTRL> __device__ __forceinline__ float dppmov(float v) {
    return __builtin_bit_cast(float, __builtin_amdgcn_update_dpp(0, __builtin_bit_cast(int, v), CTRL, 0xF, 0xF, true));
}
__device__ __forceinline__ float reduce16(float v) {
    v += dppmov<0xB1>(v); v += dppmov<0x4E>(v); v += dppmov<0x141>(v); v += dppmov<0x140>(v);
    return v;
}
__device__ __forceinline__ float sigmoidf_(float z) { return 1.0f / (1.0f + __expf(-z)); }
__device__ __forceinline__ int rho_of_d(int d) { return 8 * ((d & 31) >> 2) + 4 * (d >> 5) + (d & 3); }

__device__ __forceinline__ const float* inptr(int k) {
    const char __attribute__((address_space(4)))* kp = (const char __attribute__((address_space(4)))*)__builtin_amdgcn_kernarg_segment_ptr();
    asm volatile("" : "+s"(kp));
    return *(const float* const __attribute__((address_space(4)))*)(kp + 8 * k);
}
struct Frame {
    LAS unsigned char* lds;
    volatile LAS unsigned* MISC;
    gu32* ctl;
    int wave, vcu, G;
    float* out;
    unsigned char* ws;
};

template <int MAPMODE>
__device__ __forceinline__ void transpose_item(const float* W, int K, int N, bf16* WT, LAS float* scr, int item, int lane) {
    const int nblk = N / 32, kb = item / nblk, nb = item % nblk, k0 = 64 * kb, n0 = 32 * nb;
    f32x4 t[8];
#pragma unroll
    for (int i = 0; i < 8; ++i) t[i] = *(const GAS f32x4*)(W + (size_t)(k0 + 8 * i + (lane >> 3)) * N + n0 + 4 * (lane & 7));
#pragma unroll
    for (int i = 0; i < 8; ++i) *(LAS f32x4*)(scr + (8 * i + (lane >> 3)) * 36 + 4 * (lane & 7)) = t[i];
    LDS_WAIT(); asm volatile("" ::: "memory");
    const int c = lane & 7;
#pragma unroll
    for (int j = 0; j < 4; ++j) { const int n = (lane >> 3) + 8 * j; const LAS float* s = scr + (8 * c) * 36 + n;
        v4u o; o.x = pk2(s[0 * 36], s[1 * 36]); o.y = pk2(s[2 * 36], s[3 * 36]); o.z = pk2(s[4 * 36], s[5 * 36]); o.w = pk2(s[6 * 36], s[7 * 36]);
        int row = n0 + n;
        if (MAPMODE == 1) { if (row < 1152) row = (row & ~63) | rho_of_d(row & 63); }
        *(GAS v4u*)(WT + (size_t)row * K + k0 + 8 * c) = o; }
    LDS_WAIT(); asm volatile("" ::: "memory");
}
template <bool WF, bool WB>
__device__ __forceinline__ void ln_row(const float* src, const float* g, const float* b, float* dstf, bf16* dstb, int lane, const float* slab = nullptr, int nslab = 0) {
    const GAS f32x4* xr = (const GAS f32x4*)src + lane;
    f32x4 v[8]; float s = 0.f;
#pragma unroll
    for (int j = 0; j < 8; ++j) v[j] = xr[64 * j];
    if (nslab > 0) {
#pragma unroll
        for (int j = 0; j < 8; ++j) v[j] = v[j] * ALPHA;
        for (int k = 0; k < nslab; ++k) { const GAS f32x4* sr = (const GAS f32x4*)(slab + (size_t)k * 256 * DM) + lane;
#pragma unroll
            for (int j = 0; j < 8; ++j) v[j] = v[j] + sr[64 * j]; }
    }
#pragma unroll
    for (int j = 0; j < 8; ++j) s += (v[j].x + v[j].y) + (v[j].z + v[j].w);
    const float mean = wave_sum(s) * (1.f / DM); float s2 = 0.f;
#pragma unroll
    for (int j = 0; j < 8; ++j) { v[j] = v[j] - mean; s2 += (v[j].x * v[j].x + v[j].y * v[j].y) + (v[j].z * v[j].z + v[j].w * v[j].w); }
    const float rstd = 1.f / sqrtf(wave_sum(s2) * (1.f / DM) + LN_EPS);
#pragma unroll
    for (int j = 0; j < 8; ++j) {
        const f32x4 gg = ((const GAS f32x4*)g)[lane + 64 * j], bb = ((const GAS f32x4*)b)[lane + 64 * j];
        const f32x4 o = v[j] * rstd * gg + bb;
        if (WF) ((GAS f32x4*)dstf)[lane + 64 * j] = o;
        if (WB) { v2u w; w.x = pk2(o.x, o.y); w.y = pk2(o.z, o.w); ((GAS v2u*)dstb)[lane + 64 * j] = w; }
    }
}
__device__ __forceinline__ const float* xrow_ptr(const Frame& F, int m) { return m < NPROMPT ? inptr(0) + (size_t)m * DM : inptr(1) + (size_t)(m - NPROMPT) * DM; }

__device__ __forceinline__ void phase_p0(Frame& F) {
    LAS float* scr = (LAS float*)(F.lds + F.wave * 16384);
    const int gw = F.vcu * NWAVES + F.wave, NGW = F.G * NWAVES;
    const int gt = gw * 64 + ((int)threadIdx.x & 63), NGT = NGW * 64;
    bf16* bt1 = (bf16*)(F.ws + WS_BT1); bf16* bt2 = (bf16*)(F.ws + WS_BT2);
    constexpr int I_IN = (DM / 64) * (INC / 32), I_OUT = (DM / 64) * (DM / 32);
    for (int it = gw; it < I_IN + I_OUT; it += NGW) {
        if (it < I_IN) transpose_item<1>(inptr(9), DM, INC, bt1, scr, it, ((int)threadIdx.x & 63));
        else transpose_item<0>(inptr(22), DM, DM, bt2, scr, it - I_IN, ((int)threadIdx.x & 63));
    }
    { GAS v4u* z = (GAS v4u*)(bt1 + (size_t)INC * DM); const int nz = (N1 - INC) * DM * 2 / 16;
      for (int i = gt; i < nz; i += NGT) z[i] = (v4u){0u, 0u, 0u, 0u}; }
    { bf16* btd = (bf16*)(F.ws + WS_BTD); bf16* bta = (bf16*)(F.ws + WS_BTA); bf16* btg = (bf16*)(F.ws + WS_BTG);
      for (int i = gt; i < 1024 * 128; i += NGT) { const int n = i >> 7, k = i & 127;
          btd[i] = (bf16)(k < 64 ? f2bf(inptr(13)[k * 1024 + n]) : 0u); bta[i] = (bf16)(k < 64 ? f2bf(inptr(15)[k * 1024 + n]) : 0u); }
      for (int i = gt; i < 1024 * 256; i += NGT) { const int n = i >> 8, k = i & 255; btg[i] = (bf16)(k < 160 ? f2bf(inptr(16)[k * 1024 + n]) : 0u); } }
    { float* rope = (float*)(F.ws + WS_ROPE);
      for (int i = gt; i < 2048 * 32; i += NGT) { const int pos = i >> 5, f = i & 31;
          const float inv = powf(10000.0f, -(float)f / 32.0f); const float ang = (float)pos * inv; float sn, cs; sincosf(ang, &sn, &cs);
          rope[pos * 64 + f] = cs; rope[pos * 64 + 32 + f] = sn; } }
    { const float* ck = inptr(2); const float* cv = inptr(3);
      for (int i = gt; i < 8 * 96 * 128 / 4; i += NGT) { const int sb = i / (96 * 32), r = i % (96 * 32);
          ((GAS f32x4*)(F.out + O_SK + (size_t)sb * 128 * 128))[r] = ((const GAS f32x4*)(ck + (size_t)sb * 128 * 128 + 32 * 128))[r];
          ((GAS f32x4*)(F.out + O_SV + (size_t)sb * 128 * 128))[r] = ((const GAS f32x4*)(cv + (size_t)sb * 128 * 128 + 32 * 128))[r]; } }
    { bf16* h0b = (bf16*)(F.ws + WS_H0B);
      for (int m = gw; m < NTOK; m += NGW) ln_row<true, true>(xrow_ptr(F, m), inptr(7), inptr(8), F.out + O_Y + (size_t)m * DM, h0b + (size_t)m * DM, ((int)threadIdx.x & 63)); }
}

__device__ __forceinline__ void convert_late(Frame& F) {
    LAS float* scr = (LAS float*)(F.lds + F.wave * 16384);
    const int gw = F.vcu * NWAVES + F.wave, NGW = F.G * NWAVES;
    bf16* bt3 = (bf16*)(F.ws + WS_BT3); bf16* bt4 = (bf16*)(F.ws + WS_BT4);
    constexpr int I_UP = (DM / 64) * (NUP / 32), I_DN = (DFF / 64) * (DM / 32);
    for (int it = gw; it < I_UP + I_DN; it += NGW) {
        if (it < I_UP) transpose_item<0>(inptr(25), DM, NUP, bt3, scr, it, ((int)threadIdx.x & 63));
        else transpose_item<0>(inptr(28), DFF, DM, bt4, scr, it - I_UP, ((int)threadIdx.x & 63));
    }
}

using pg8::Unit;
#define EPI_ROWS_BEGIN  _Pragma("unroll") for (int ai = 0; ai < 2; ++ai) _Pragma("unroll") for (int m = 0; m < 4; ++m) { const int row = u.pm * 256 + ai * 128 + wr * 64 + m * 16 + fr;
#define EPI_ROWS_END }
struct EpiIn {
    static constexpr bool PERM = true;
    bf16* mix; bf16* kb; bf16* vb; bf16* prw; const float* rope; float* out;
    __device__ __forceinline__ void operator()(const f32x4 (&acc)[2][2][4][2], const Unit& u, int wr, int wc, int fr, int fq) const {
        const int cw = wc * 32 + 8 * fq;
        if (u.pn < 4) {
            const int d0 = 4 * (((cw & 63) >> 3));
            EPI_ROWS_BEGIN
                const RowInfo ri = rowinfo(row);
                const f32x4 cs = *(const GAS f32x4*)(rope + ri.pos * 64 + d0), sn = *(const GAS f32x4*)(rope + ri.pos * 64 + 32 + d0);
#pragma unroll
                for (int bj = 0; bj < 2; ++bj) {
                    const f32x4 x1 = acc[ai][bj][m][0], x2 = acc[ai][bj][m][1];
                    const f32x4 o1 = (x1 * cs - x2 * sn) * 0.125f, o2 = (x2 * cs + x1 * sn) * 0.125f;
                    v4u w; w.x = pk2(o1.x, o1.y); w.y = pk2(o1.z, o1.w); w.z = pk2(o2.x, o2.y); w.w = pk2(o2.z, o2.w);
                    *(GAS v4u*)(mix + (size_t)row * DM + u.pn * 256 + bj * 128 + cw) = w;
                }
            EPI_ROWS_END
        } else if (u.pn == 4) {
            const int kvh = cw >> 6, d0 = 4 * ((cw & 63) >> 3);
            EPI_ROWS_BEGIN
                const RowInfo ri = rowinfo(row);
                const int wrow = ri.t - (ri.L - 128);
                float* ok = (ri.seq < 4) ? out + O_PK + (size_t)ri.seq * 128 * 128 : out + O_SK + (size_t)(ri.seq - 4) * 128 * 128;
                float* ov = (ri.seq < 4) ? out + O_PV + (size_t)ri.seq * 128 * 128 : out + O_SV + (size_t)(ri.seq - 4) * 128 * 128;
                {
                    const f32x4 cs = *(const GAS f32x4*)(rope + ri.pos * 64 + d0), sn = *(const GAS f32x4*)(rope + ri.pos * 64 + 32 + d0);
                    const f32x4 x1 = acc[ai][0][m][0], x2 = acc[ai][0][m][1];
                    const f32x4 o1 = x1 * cs - x2 * sn, o2 = x2 * cs + x1 * sn;
                    v4u w; w.x = pk2(o1.x, o1.y); w.y = pk2(o1.z, o1.w); w.z = pk2(o2.x, o2.y); w.w = pk2(o2.z, o2.w);
                    *(GAS v4u*)(kb + (size_t)row * 128 + cw) = w;
                    if (wrow >= 0) { *(GAS f32x4*)(ok + (size_t)wrow * 128 + kvh * 64 + d0) = o1; *(GAS f32x4*)(ok + (size_t)wrow * 128 + kvh * 64 + 32 + d0) = o2; }
                }
                {
                    const f32x4 x1 = acc[ai][1][m][0], x2 = acc[ai][1][m][1];
                    v4u w; w.x = pk2(x1.x, x1.y); w.y = pk2(x1.z, x1.w); w.z = pk2(x2.x, x2.y); w.w = pk2(x2.z, x2.w);
                    *(GAS v4u*)(vb + (size_t)row * 128 + cw) = w;
                    if (wrow >= 0) { *(GAS f32x4*)(ov + (size_t)wrow * 128 + cw) = x1; *(GAS f32x4*)(ov + (size_t)wrow * 128 + cw + 4) = x2; }
                }
            EPI_ROWS_END
        } else {
            EPI_ROWS_BEGIN
                const RowInfo ri = rowinfo(row);
                float* osh = (ri.seq < 4) ? out + O_PSHIFT + (size_t)ri.seq * RWC : out + O_SSHIFT + (size_t)(ri.seq - 4) * RWC;
#pragma unroll
                for (int bj = 0; bj < 2; ++bj) {
                    const int col = (u.pn - 5) * 256 + bj * 128 + cw;
                    if (col < RWC) {
                        const f32x4 x1 = acc[ai][bj][m][0], x2 = acc[ai][bj][m][1];
                        v4u w; w.x = pk2(x1.x, x1.y); w.y = pk2(x1.z, x1.w); w.z = pk2(x2.x, x2.y); w.w = pk2(x2.z, x2.w);
                        *(GAS v4u*)(prw + (size_t)row * PRW_LD + col) = w;
                        if (ri.t == ri.L - 1) { *(GAS f32x4*)(osh + col) = x1; *(GAS f32x4*)(osh + col + 4) = x2; }
                    }
                }
            EPI_ROWS_END
        }
    }
};
struct EpiDecay {
    static constexpr bool PERM = true;
    float* rec; const float* w0;
    __device__ __forceinline__ void operator()(const f32x4 (&acc)[2][2][4][2], const Unit& u, int wr, int wc, int fr, int fq) const {
        EPI_ROWS_BEGIN
#pragma unroll
            for (int bj = 0; bj < 2; ++bj) {
                const int c = u.pn * 256 + bj * 128 + wc * 32 + 8 * fq, h = c >> 6, j = c & 63;
                float* dst = rec + ((size_t)row * 16 + h) * 320 + 2 * 64 + j;
#pragma unroll
                for (int n = 0; n < 2; ++n) { const f32x4 z = acc[ai][bj][m][n] + *(const GAS f32x4*)(w0 + c + 4 * n); f32x4 o;
                    o.x = __expf(-0.6065306597126334f * sigmoidf_(z.x)); o.y = __expf(-0.6065306597126334f * sigmoidf_(z.y));
                    o.z = __expf(-0.6065306597126334f * sigmoidf_(z.z)); o.w = __expf(-0.6065306597126334f * sigmoidf_(z.w));
                    *(GAS f32x4*)(dst + 4 * n) = o; }
            }
        EPI_ROWS_END
    }
};
template <int MODE>
struct EpiVec {
    static constexpr bool PERM = true;
    bf16* dst; const float* bias;
    __device__ __forceinline__ void operator()(const f32x4 (&acc)[2][2][4][2], const Unit& u, int wr, int wc, int fr, int fq) const {
        EPI_ROWS_BEGIN
#pragma unroll
            for (int bj = 0; bj < 2; ++bj) {
                const int c = u.pn * 256 + bj * 128 + wc * 32 + 8 * fq;
                f32x4 x1 = acc[ai][bj][m][0], x2 = acc[ai][bj][m][1];
                if (MODE == 0) { x1 = x1 + *(const GAS f32x4*)(bias + c); x2 = x2 + *(const GAS f32x4*)(bias + c + 4);
                    x1.x = sigmoidf_(x1.x); x1.y = sigmoidf_(x1.y); x1.z = sigmoidf_(x1.z); x1.w = sigmoidf_(x1.w);
                    x2.x = sigmoidf_(x2.x); x2.y = sigmoidf_(x2.y); x2.z = sigmoidf_(x2.z); x2.w = sigmoidf_(x2.w); }
                v4u w; w.x = pk2(x1.x, x1.y); w.y = pk2(x1.z, x1.w); w.z = pk2(x2.x, x2.y); w.w = pk2(x2.z, x2.w);
                *(GAS v4u*)(dst + (size_t)row * 1024 + c) = w;
            }
        EPI_ROWS_END
    }
};
struct EpiRes {
    static constexpr bool PERM = true;
    float* y;
    __device__ __forceinline__ void operator()(const f32x4 (&acc)[2][2][4][2], const Unit& u, int wr, int wc, int fr, int fq) const {
        EPI_ROWS_BEGIN
#pragma unroll
            for (int bj = 0; bj < 2; ++bj) {
                const int c = u.pn * 256 + bj * 128 + wc * 32 + 8 * fq;
                GAS f32x4* p = (GAS f32x4*)(y + (size_t)row * DM + c);
                const f32x4 r0 = p[0], r1 = p[1];
                p[0] = r0 * ALPHA + acc[ai][bj][m][0]; p[1] = r1 * ALPHA + acc[ai][bj][m][1];
            }
        EPI_ROWS_END
    }
};
struct EpiSlab {
    static constexpr bool PERM = true;
    float* slab;
    __device__ __forceinline__ void operator()(const f32x4 (&acc)[2][2][4][2], const Unit& u, int wr, int wc, int fr, int fq) const {
        float* sl = slab + (size_t)u.ks * 256 * DM;
#pragma unroll
        for (int ai = 0; ai < 2; ++ai)
#pragma unroll
            for (int m = 0; m < 4; ++m) { const int lr = ai * 128 + wr * 64 + m * 16 + fr;
#pragma unroll
                for (int bj = 0; bj < 2; ++bj) { const int c = u.pn * 256 + bj * 128 + wc * 32 + 8 * fq; GAS f32x4* p = (GAS f32x4*)(sl + (size_t)lr * DM + c); p[0] = acc[ai][bj][m][0]; p[1] = acc[ai][bj][m][1]; } }
    }
};
struct EpiUp {
    static constexpr bool PERM = true;
    bf16* up; float* out;
    __device__ __forceinline__ void operator()(const f32x4 (&acc)[2][2][4][2], const Unit& u, int wr, int wc, int fr, int fq) const {
        EPI_ROWS_BEGIN
            const RowInfo ri = rowinfo(row);
            const int cr = ri.t - (ri.L - 2);
            float* oc = (ri.seq < 4) ? out + O_PCONV + (size_t)ri.seq * 2 * NUP : out + O_SCONV + (size_t)(ri.seq - 4) * 2 * NUP;
#pragma unroll
            for (int bj = 0; bj < 2; ++bj) {
                const int c = u.pn * 256 + bj * 128 + wc * 32 + 8 * fq;
                const f32x4 x1 = acc[ai][bj][m][0], x2 = acc[ai][bj][m][1];
                v4u w; w.x = pk2(x1.x, x1.y); w.y = pk2(x1.z, x1.w); w.z = pk2(x2.x, x2.y); w.w = pk2(x2.z, x2.w);
                *(GAS v4u*)(up + (size_t)row * NUP + c) = w;
                if (cr >= 0) { *(GAS f32x4*)(oc + (size_t)cr * NUP + c) = x1; *(GAS f32x4*)(oc + (size_t)cr * NUP + c + 4) = x2; }
            }
        EPI_ROWS_END
    }
};

__device__ __forceinline__ void phase_prep_a(Frame& F) {
    const int gw = F.vcu * NWAVES + F.wave, NGW = F.G * NWAVES, l = ((int)threadIdx.x & 63);
    const bf16* prw = (const bf16*)(F.ws + WS_PRW); bf16* al = (bf16*)(F.ws + WS_ALORA);
    const float* mu = inptr(11); const float* sshift = inptr(5);
    int src = -1, mode = 0;
    if (l < 8) { src = RC_WD + 8 * l; mode = 1; } else if (l >= 16 && l < 24) { src = RC_AD + 8 * (l - 16); mode = 2; } else if (l >= 32 && l < 52) { src = RC_GD + 8 * (l - 32); mode = 3; }
    for (int m = gw; m < NTOK; m += NGW) {
        v4u o = (v4u){0u, 0u, 0u, 0u};
        if (src >= 0) {
            const RowInfo ri = rowinfo(m);
            const v4u pc = *(const GAS v4u*)(prw + (size_t)m * PRW_LD + src);
            float p[8] = {bf_lo(pc.x), bf_hi(pc.x), bf_lo(pc.y), bf_hi(pc.y), bf_lo(pc.z), bf_hi(pc.z), bf_lo(pc.w), bf_hi(pc.w)};
            float pv[8];
            if (ri.t > 0) { const v4u pp = *(const GAS v4u*)(prw + (size_t)(m - 1) * PRW_LD + src);
                pv[0] = bf_lo(pp.x); pv[1] = bf_hi(pp.x); pv[2] = bf_lo(pp.y); pv[3] = bf_hi(pp.y); pv[4] = bf_lo(pp.z); pv[5] = bf_hi(pp.z); pv[6] = bf_lo(pp.w); pv[7] = bf_hi(pp.w); }
            else if (ri.seq >= 4) {
#pragma unroll
                for (int i = 0; i < 8; ++i) pv[i] = sshift[(size_t)(ri.seq - 4) * RWC + src + i]; }
            else {
#pragma unroll
                for (int i = 0; i < 8; ++i) pv[i] = 0.f; }
            float x[8];
#pragma unroll
            for (int i = 0; i < 8; ++i) { const float xs = p[i] + (pv[i] - p[i]) * mu[src + i];
                x[i] = mode == 1 ? tanhf(xs) : (mode == 3 ? sigmoidf_(xs) : xs); }
            o.x = pk2(x[0], x[1]); o.y = pk2(x[2], x[3]); o.z = pk2(x[4], x[5]); o.w = pk2(x[6], x[7]);
        }
        *(GAS v4u*)(al + (size_t)m * 512 + 8 * l) = o;
    }
}

__device__ __forceinline__ void phase_prep_b(Frame& F) {
    const int gw = F.vcu * NWAVES + F.wave, NGW = F.G * NWAVES, l = ((int)threadIdx.x & 63);
    const bf16* prw = (const bf16*)(F.ws + WS_PRW); const bf16* asig = (const bf16*)(F.ws + WS_ASIG);
    float* rec = (float*)(F.ws + WS_REC); bf16* vcopy = (bf16*)(F.ws + WS_VCOPY); float* rkr = (float*)(F.ws + WS_RKR);
    const float* mu = inptr(11); const float* sshift = inptr(5);
    for (int it = gw; it < NTOK * 4; it += NGW) {
        const int m = it >> 2, q4 = it & 3, c = 256 * q4 + 4 * l, h = c >> 6, j = c & 63;
        const RowInfo ri = rowinfo(m);
        float xr[4], xk[4], xv[4];
#pragma unroll
        for (int part = 0; part < 3; ++part) {
            const int col = (part == 0 ? RC_R : (part == 1 ? RC_K : RC_V)) + c;
            const v2u pc = *(const GAS v2u*)(prw + (size_t)m * PRW_LD + col);
            const float p[4] = {bf_lo(pc.x), bf_hi(pc.x), bf_lo(pc.y), bf_hi(pc.y)};
            float pv[4];
            if (ri.t > 0) { const v2u pp = *(const GAS v2u*)(prw + (size_t)(m - 1) * PRW_LD + col); pv[0] = bf_lo(pp.x); pv[1] = bf_hi(pp.x); pv[2] = bf_lo(pp.y); pv[3] = bf_hi(pp.y); }
            else if (ri.seq >= 4) { const f32x4 s = *(const GAS f32x4*)(sshift + (size_t)(ri.seq - 4) * RWC + col); pv[0] = s.x; pv[1] = s.y; pv[2] = s.z; pv[3] = s.w; }
            else { pv[0] = pv[1] = pv[2] = pv[3] = 0.f; }
            const f32x4 mm = *(const GAS f32x4*)(mu + col);
            const float mv[4] = {mm.x, mm.y, mm.z, mm.w};
#pragma unroll
            for (int i = 0; i < 4; ++i) { const float xs = p[i] + (pv[i] - p[i]) * mv[i]; if (part == 0) xr[i] = xs; else if (part == 1) xk[i] = xs; else xv[i] = xs; }
        }
        const v2u ac = *(const GAS v2u*)(asig + (size_t)m * 1024 + c);
        const float a[4] = {bf_lo(ac.x), bf_hi(ac.x), bf_lo(ac.y), bf_hi(ac.y)};
        const f32x4 kkw = *(const GAS f32x4*)(inptr(17) + c), kaw = *(const GAS f32x4*)(inptr(18) + c), rkw = *(const GAS f32x4*)(inptr(19) + c);
        const float kkv[4] = {kkw.x, kkw.y, kkw.z, kkw.w}, kav[4] = {kaw.x, kaw.y, kaw.z, kaw.w}, rkv[4] = {rkw.x, rkw.y, rkw.z, rkw.w};
        float kk[4], kp[4]; float ss = 0.f, rs = 0.f;
#pragma unroll
        for (int i = 0; i < 4; ++i) { kk[i] = xk[i] * kkv[i]; ss += kk[i] * kk[i]; kp[i] = xk[i] * (1.0f + (a[i] - 1.0f) * kav[i]); rs += xr[i] * kp[i] * rkv[i]; }
        ss = reduce16(ss); rs = reduce16(rs);
        const float inv = 1.0f / fmaxf(sqrtf(ss), 1e-12f);
        float* rp = rec + ((size_t)m * 16 + h) * 320 + j;
        f32x4 A, B;
        A.x = -kk[0] * inv; A.y = -kk[1] * inv; A.z = -kk[2] * inv; A.w = -kk[3] * inv;
        B.x = -A.x * a[0]; B.y = -A.y * a[1]; B.z = -A.z * a[2]; B.w = -A.w * a[3];
        *(GAS f32x4*)(rp) = A;
        *(GAS f32x4*)(rp + 64) = (f32x4){xr[0], xr[1], xr[2], xr[3]};
        *(GAS f32x4*)(rp + 192) = B;
        *(GAS f32x4*)(rp + 256) = (f32x4){kp[0], kp[1], kp[2], kp[3]};
        v2u vw; vw.x = pk2(xv[0], xv[1]); vw.y = pk2(xv[2], xv[3]);
        *(GAS v2u*)(vcopy + (size_t)m * 1024 + c) = vw;
        if ((l & 15) == 0) rkr[m * 16 + h] = rs;
    }
}

constexpr int KS_LD = 72, VT_LD = 200;
constexpr int ATT_KS_OFF = 0, ATT_VT_OFF = 192 * KS_LD * 2;
__device__ __forceinline__ void attn_unit(Frame& F, int u) {
    const bf16* kb = (const bf16*)(F.ws + WS_KB); const bf16* vb = (const bf16*)(F.ws + WS_VB); bf16* mix = (bf16*)(F.ws + WS_MIX);
    LAS bf16* Ks = (LAS bf16*)(F.lds + ATT_KS_OFF); LAS bf16* Vt = (LAS bf16*)(F.lds + ATT_VT_OFF);
    const int tid = ((int)threadIdx.x), lane = ((int)threadIdx.x & 63), wave = F.wave;
    int row0, nqt, nkt, kvh, krow0, ncache = 0, sb = 0;
    if (u < 256) { const int b = u >> 6, n = (u >> 1) & 31; kvh = u & 1; row0 = b * 2048 + 64 * n; nqt = 2; const int back = n < 2 ? n : 2; krow0 = row0 - 64 * back; nkt = 2 * (back + 1); }
    else { sb = (u - 256) >> 1; kvh = u & 1; row0 = NPROMPT + 32 * sb; nqt = 1; krow0 = row0; nkt = 5; ncache = 128; }
    const int nkeys = 32 * nkt;
    __syncthreads();
    for (int i = tid; i < nkeys * 8; i += 512) {
        const int key = i >> 3, dg = i & 7;
        v4u kw, vw;
        if (key < ncache) {
            const float* ck = inptr(2) + ((size_t)(sb * 128 + key) * 2 + kvh) * 64; const float* cv = inptr(3) + ((size_t)(sb * 128 + key) * 2 + kvh) * 64;
            const f32x4 k1 = *(const GAS f32x4*)(ck + 4 * dg), k2 = *(const GAS f32x4*)(ck + 32 + 4 * dg);
            kw.x = pk2(k1.x, k1.y); kw.y = pk2(k1.z, k1.w); kw.z = pk2(k2.x, k2.y); kw.w = pk2(k2.z, k2.w);
            const f32x4 v1 = *(const GAS f32x4*)(cv + 8 * dg), v2 = *(const GAS f32x4*)(cv + 8 * dg + 4);
            vw.x = pk2(v1.x, v1.y); vw.y = pk2(v1.z, v1.w); vw.z = pk2(v2.x, v2.y); vw.w = pk2(v2.z, v2.w);
        } else {
            const size_t r = (size_t)(krow0 + key - ncache);
            kw = *(const GAS v4u*)(kb + r * 128 + kvh * 64 + 8 * dg);
            vw = *(const GAS v4u*)(vb + r * 128 + kvh * 64 + 8 * dg);
        }
        *(LAS v4u*)(Ks + key * KS_LD + 8 * dg) = kw;
        LAS bf16* vt = Vt + (8 * dg) * VT_LD + key;
        vt[0 * VT_LD] = (bf16)(vw.x & 0xffffu); vt[1 * VT_LD] = (bf16)(vw.x >> 16); vt[2 * VT_LD] = (bf16)(vw.y & 0xffffu); vt[3 * VT_LD] = (bf16)(vw.y >> 16);
        vt[4 * VT_LD] = (bf16)(vw.z & 0xffffu); vt[5 * VT_LD] = (bf16)(vw.z >> 16); vt[6 * VT_LD] = (bf16)(vw.w & 0xffffu); vt[7 * VT_LD] = (bf16)(vw.w >> 16);
    }
    __syncthreads();
    const int hq = kvh * 8 + wave, r = lane & 31, h = lane >> 5;
    const float sink = inptr(10)[hq];
    for (int qt = 0; qt < nqt; ++qt) {
        bf16* qrow = mix + (size_t)(row0 + 32 * qt + r) * DM + hq * 64;
        bf16x8 qf[4];
#pragma unroll
        for (int ds = 0; ds < 4; ++ds) qf[ds] = *(const GAS bf16x8*)(qrow + 16 * ds + 8 * h);
        f32x16 X[6];
#pragma unroll
        for (int kt = 0; kt < 6; ++kt) {
#pragma unroll
            for (int e = 0; e < 16; ++e) X[kt][e] = 0.f;
            if (kt < nkt) {
#pragma unroll
                for (int ds = 0; ds < 4; ++ds) { const bf16x8 kf = *(const LAS bf16x8*)(Ks + (32 * kt + r) * KS_LD + 16 * ds + 8 * h);
                    X[kt] = __builtin_amdgcn_mfma_f32_32x32x16_bf16(kf, qf[ds], X[kt], 0, 0, 0); }
            }
        }
        float mx = sink;
#pragma unroll
        for (int kt = 0; kt < 6; ++kt) if (kt < nkt) {
#pragma unroll
            for (int e = 0; e < 16; ++e) mx = fmaxf(mx, X[kt][e]); }
        mx = fmaxf(mx, __shfl_xor(mx, 32));
        float sum = 0.f;
#pragma unroll
        for (int kt = 0; kt < 6; ++kt) if (kt < nkt) {
#pragma unroll
            for (int e = 0; e < 16; ++e) { const float p = __expf(X[kt][e] - mx); X[kt][e] = p; sum += p; } }
        sum += __shfl_xor(sum, 32);
        const float invden = 1.0f / (sum + __expf(sink - mx));
        f32x16 O[2];
#pragma unroll
        for (int dt = 0; dt < 2; ++dt)
#pragma unroll
            for (int e = 0; e < 16; ++e) O[dt][e] = 0.f;
#pragma unroll
        for (int kt = 0; kt < 6; ++kt) if (kt < nkt) {
#pragma unroll
            for (int s = 0; s < 2; ++s) {
                v4u pw; pw.x = pk2(X[kt][8 * s + 0], X[kt][8 * s + 1]); pw.y = pk2(X[kt][8 * s + 2], X[kt][8 * s + 3]); pw.z = pk2(X[kt][8 * s + 4], X[kt][8 * s + 5]); pw.w = pk2(X[kt][8 * s + 6], X[kt][8 * s + 7]);
                const bf16x8 pb = __builtin_bit_cast(bf16x8, pw);
#pragma unroll
                for (int dt = 0; dt < 2; ++dt) {
                    const LAS bf16* vp = Vt + (32 * dt + r) * VT_LD + 32 * kt + 16 * s + 4 * h;
                    const v2u a0 = *(const LAS v2u*)(vp), a1 = *(const LAS v2u*)(vp + 8);
                    v4u aw; aw.x = a0.x; aw.y = a0.y; aw.z = a1.x; aw.w = a1.y;
                    O[dt] = __builtin_amdgcn_mfma_f32_32x32x16_bf16(__builtin_bit_cast(bf16x8, aw), pb, O[dt], 0, 0, 0);
                }
            }
        }
#pragma unroll
        for (int dt = 0; dt < 2; ++dt)
#pragma unroll
            for (int g4 = 0; g4 < 4; ++g4) {
                v2u w; w.x = pk2(O[dt][4 * g4 + 0] * invden, O[dt][4 * g4 + 1] * invden); w.y = pk2(O[dt][4 * g4 + 2] * invden, O[dt][4 * g4 + 3] * invden);
                *(GAS v2u*)(qrow + 32 * dt + 8 * g4 + 4 * h) = w;
            }
    }
}

constexpr int SC_BUF = 32 * 5 * 64 * 4 + 32 * 16 * 4;
__device__ __forceinline__ void scan_job(Frame& F, int m0, int T, int hh, int q, const float* s_in, float* s_out) {
    const float* rec = (const float*)(F.ws + WS_REC); const bf16* vcopy = (const bf16*)(F.ws + WS_VCOPY); float* og = (float*)(F.ws + WS_O);
    const int tid = ((int)threadIdx.x), lane = ((int)threadIdx.x & 63), wave = F.wave;
    const int st = tid >> 4, part = tid & 15;
    const int nch = T / 32;
    f32x4 rg[5]; float vr;
#define SC_LOAD(c_) do { const size_t m_ = (size_t)(m0 + 32 * (c_) + st); const float* rp_ = rec + (m_ * 16 + hh) * 320 + part * 4; \
        _Pragma("unroll") for (int k = 0; k < 5; ++k) rg[k] = *(const GAS f32x4*)(rp_ + k * 64); \
        vr = __builtin_bit_cast(float, (unsigned)vcopy[m_ * 1024 + hh * 64 + 16 * q + part] << 16); } while (0)
#define SC_WRITE(b_) do { LAS float* buf_ = (LAS float*)(F.lds + (b_) * SC_BUF); \
        _Pragma("unroll") for (int k = 0; k < 5; ++k) *(LAS f32x4*)(buf_ + (st * 5 + k) * 64 + part * 4) = rg[k]; \
        buf_[32 * 320 + st * 16 + part] = vr; } while (0)
    const int rgp = lane >> 4, cl = lane & 15, irow = 16 * q + 4 * (wave & 3) + rgp, j0 = 4 * cl;
    f32x4 S = (f32x4){0.f, 0.f, 0.f, 0.f};
    if (s_in && wave < 4) S = *(const GAS f32x4*)(s_in + (size_t)irow * 64 + j0);
    __syncthreads();
    SC_LOAD(0); SC_WRITE(0);
    if (nch > 1) SC_LOAD(1);
    for (int c = 0; c < nch; ++c) {
        __syncthreads();
        if (c + 1 < nch) SC_WRITE((c + 1) & 1);
        if (c + 2 < nch) SC_LOAD(c + 2);
        if (wave < 4) {
            const LAS float* buf = (const LAS float*)(F.lds + (c & 1) * SC_BUF);
            const LAS float* bp = buf + j0;
            const LAS float* vp = buf + 32 * 320 + 4 * (wave & 3) + rgp;
            float* op = og + (size_t)(m0 + 32 * c + cl) * 1024 + hh * 64 + irow;
            f32x4 A = *(const LAS f32x4*)(bp), R = *(const LAS f32x4*)(bp + 64), W = *(const LAS f32x4*)(bp + 128), B = *(const LAS f32x4*)(bp + 192), Kv = *(const LAS f32x4*)(bp + 256);
            float v = vp[0], ov = 0.f, pprev = 0.f;
            f32x2 S01 = (f32x2){S.x, S.y}, S23 = (f32x2){S.z, S.w};
#pragma unroll
            for (int s = 0; s < 32; ++s) {
                f32x4 nA, nR, nW, nB, nK; float nv;
                if (s < 31) { const LAS float* np = bp + (s + 1) * 320;
                    nA = *(const LAS f32x4*)(np); nR = *(const LAS f32x4*)(np + 64); nW = *(const LAS f32x4*)(np + 128); nB = *(const LAS f32x4*)(np + 192); nK = *(const LAS f32x4*)(np + 256); nv = vp[(s + 1) * 16]; }
                __builtin_amdgcn_sched_barrier(0);
                f32x2 t = S01 * (f32x2){A.x, A.y}; t = S23 * (f32x2){A.z, A.w} + t;
                const f32x2 c01 = S01 * (f32x2){W.x, W.y} + (f32x2){Kv.x, Kv.y} * v, c23 = S23 * (f32x2){W.z, W.w} + (f32x2){Kv.z, Kv.w} * v;
                const float sa = reduce16(t.x + t.y);
                if (s > 0) { const float po = reduce16(pprev); ov = (cl == ((s - 1) & 15)) ? po : ov; if (((s - 1) & 15) == 15) op[(size_t)(s - 16) * 1024] = ov; }
                S01 = (f32x2){B.x, B.y} * sa + c01; S23 = (f32x2){B.z, B.w} * sa + c23;
                f32x2 u = S01 * (f32x2){R.x, R.y}; u = S23 * (f32x2){R.z, R.w} + u;
                pprev = u.x + u.y;
                if (s < 31) { A = nA; R = nR; W = nW; B = nB; Kv = nK; v = nv; }
            }
            { const float po = reduce16(pprev); ov = (cl == 15) ? po : ov; op[(size_t)16 * 1024] = ov; }
            S = (f32x4){S01.x, S01.y, S23.x, S23.y};
        }
    }
    if (wave < 4) *(GAS f32x4*)(s_out + (size_t)irow * 64 + j0) = S;
}

__device__ __forceinline__ void phase_scan(Frame& F) {
    for (int u = F.vcu; u < 272; u += F.G) attn_unit(F, u);
    REP(5) for (int j = F.vcu; j < 256; j += F.G) {
        const int chain = j >> 2, q = j & 3, b = chain >> 4, hh = chain & 15;
        scan_job(F, b * 2048, 2048, hh, q, nullptr, F.out + O_PWKV + ((size_t)(b * 16 + hh)) * 4096);
    }
    for (int j = F.vcu; j < 512; j += F.G) {
        const int chain = j >> 2, q = j & 3, sb = chain >> 4, hh = chain & 15;
        scan_job(F, NPROMPT + 32 * sb, 32, hh, q, inptr(4) + ((size_t)(sb * 16 + hh)) * 4096, F.out + O_SWKV + ((size_t)(sb * 16 + hh)) * 4096);
    }
    __syncthreads();
    REP(13) convert_late(F);
}

__device__ __forceinline__ void phase_post(Frame& F) {
    const int gw = F.vcu * NWAVES + F.wave, NGW = F.G * NWAVES, l = ((int)threadIdx.x & 63);
    const float* og = (const float*)(F.ws + WS_O); const bf16* vcopy = (const bf16*)(F.ws + WS_VCOPY); const bf16* gb = (const bf16*)(F.ws + WS_G);
    const float* rkr = (const float*)(F.ws + WS_RKR); bf16* mix = (bf16*)(F.ws + WS_MIX);
    for (int it = gw; it < NTOK * 4; it += NGW) {
        const int m = it >> 2, q4 = it & 3, c = 256 * q4 + 4 * l, h = c >> 6;
        const f32x4 o = *(const GAS f32x4*)(og + (size_t)m * 1024 + c);
        const float mo = reduce16((o.x + o.y) + (o.z + o.w)) * (1.0f / 64.0f);
        const f32x4 d = o - mo;
        const float vo = reduce16((d.x * d.x + d.y * d.y) + (d.z * d.z + d.w * d.w)) * (1.0f / 64.0f);
        const float rstd = 1.0f / sqrtf(vo + LNX_EPS);
        const f32x4 lg = *(const GAS f32x4*)(inptr(20) + c), lb = *(const GAS f32x4*)(inptr(21) + c);
        const v2u vc = *(const GAS v2u*)(vcopy + (size_t)m * 1024 + c), gc = *(const GAS v2u*)(gb + (size_t)m * 1024 + c);
        const f32x4 v = (f32x4){bf_lo(vc.x), bf_hi(vc.x), bf_lo(vc.y), bf_hi(vc.y)}, g = (f32x4){bf_lo(gc.x), bf_hi(gc.x), bf_lo(gc.y), bf_hi(gc.y)};
        const float bs = rkr[m * 16 + h];
        const f32x4 res = (d * rstd * lg + lb + v * bs) * g;
        v2u w; w.x = pk2(res.x, res.y); w.y = pk2(res.z, res.w);
        *(GAS v2u*)(mix + (size_t)m * DM + 1024 + c) = w;
    }
}

template <bool WB>
__device__ __forceinline__ void phase_ln(Frame& F, const float* g, const float* b, bf16* dstb, int nslab) {
    const int gw = F.vcu * NWAVES + F.wave, NGW = F.G * NWAVES;
    const float* slab = (const float*)(F.ws + WS_SLAB);
    for (int m = NTOK - 1 - gw; m >= 0; m -= NGW) { float* y = F.out + O_Y + (size_t)m * DM;
        const bool sm = m >= NPROMPT;
        ln_row<true, WB>(y, g, b, y, WB ? dstb + (size_t)m * DM : nullptr, ((int)threadIdx.x & 63), sm ? slab + (size_t)(m - NPROMPT) * DM : nullptr, sm ? nslab : 0); }
}

__device__ __forceinline__ void phase_conv(Frame& F) {
    const int gw = F.vcu * NWAVES + F.wave, NGW = F.G * NWAVES, l = ((int)threadIdx.x & 63);
    const bf16* up = (const bf16*)(F.ws + WS_UP); bf16* act = (bf16*)(F.ws + WS_ACT);
    const float* cw = inptr(26); const float* cb = inptr(27); const float* sconv = inptr(6);
    constexpr int NRUN = NTOK / 16, NCG = DFF / 512;
    for (int it = gw; it < NRUN * NCG; it += NGW) {
        const int run = it / NCG, cgp = it % NCG, m0 = run * 16, j0 = cgp * 512 + 8 * l;
        const RowInfo ri = rowinfo(m0);
        float wg[3][8], wv[3][8], bg[8], bv[8];
#pragma unroll
        for (int i = 0; i < 3; ++i)
#pragma unroll
            for (int e = 0; e < 8; e += 4) { const f32x4 a = *(const GAS f32x4*)(cw + (size_t)i * NUP + j0 + e), b = *(const GAS f32x4*)(cw + (size_t)i * NUP + DFF + j0 + e);
                wg[i][e] = a.x; wg[i][e + 1] = a.y; wg[i][e + 2] = a.z; wg[i][e + 3] = a.w; wv[i][e] = b.x; wv[i][e + 1] = b.y; wv[i][e + 2] = b.z; wv[i][e + 3] = b.w; }
#pragma unroll
        for (int e = 0; e < 8; e += 4) { const f32x4 a = *(const GAS f32x4*)(cb + j0 + e), b = *(const GAS f32x4*)(cb + DFF + j0 + e);
            bg[e] = a.x; bg[e + 1] = a.y; bg[e + 2] = a.z; bg[e + 3] = a.w; bv[e] = b.x; bv[e + 1] = b.y; bv[e + 2] = b.z; bv[e + 3] = b.w; }
        float g2[8], g1[8], v2[8], v1[8];
        if (ri.t == 0) {
            if (ri.seq >= 4) { const float* sp = sconv + (size_t)(ri.seq - 4) * 2 * NUP;
#pragma unroll
                for (int e = 0; e < 8; ++e) { g2[e] = sp[j0 + e]; v2[e] = sp[DFF + j0 + e]; g1[e] = sp[NUP + j0 + e]; v1[e] = sp[NUP + DFF + j0 + e]; } }
            else {
#pragma unroll
                for (int e = 0; e < 8; ++e) { g2[e] = v2[e] = g1[e] = v1[e] = 0.f; } }
        } else {
            const v4u a2 = *(const GAS v4u*)(up + (size_t)(m0 - 2) * NUP + j0), b2 = *(const GAS v4u*)(up + (size_t)(m0 - 2) * NUP + DFF + j0);
            const v4u a1 = *(const GAS v4u*)(up + (size_t)(m0 - 1) * NUP + j0), b1 = *(const GAS v4u*)(up + (size_t)(m0 - 1) * NUP + DFF + j0);
            g2[0] = bf_lo(a2.x); g2[1] = bf_hi(a2.x); g2[2] = bf_lo(a2.y); g2[3] = bf_hi(a2.y); g2[4] = bf_lo(a2.z); g2[5] = bf_hi(a2.z); g2[6] = bf_lo(a2.w); g2[7] = bf_hi(a2.w);
            v2[0] = bf_lo(b2.x); v2[1] = bf_hi(b2.x); v2[2] = bf_lo(b2.y); v2[3] = bf_hi(b2.y); v2[4] = bf_lo(b2.z); v2[5] = bf_hi(b2.z); v2[6] = bf_lo(b2.w); v2[7] = bf_hi(b2.w);
            g1[0] = bf_lo(a1.x); g1[1] = bf_hi(a1.x); g1[2] = bf_lo(a1.y); g1[3] = bf_hi(a1.y); g1[4] = bf_lo(a1.z); g1[5] = bf_hi(a1.z); g1[6] = bf_lo(a1.w); g1[7] = bf_hi(a1.w);
            v1[0] = bf_lo(b1.x); v1[1] = bf_hi(b1.x); v1[2] = bf_lo(b1.y); v1[3] = bf_hi(b1.y); v1[4] = bf_lo(b1.z); v1[5] = bf_hi(b1.z); v1[6] = bf_lo(b1.w); v1[7] = bf_hi(b1.w);
        }
#pragma unroll 2
        for (int rr = 0; rr < 16; ++rr) {
            const size_t m = (size_t)(m0 + rr);
            const v4u a0 = *(const GAS v4u*)(up + m * NUP + j0), b0 = *(const GAS v4u*)(up + m * NUP + DFF + j0);
            float g0[8], v0[8];
            g0[0] = bf_lo(a0.x); g0[1] = bf_hi(a0.x); g0[2] = bf_lo(a0.y); g0[3] = bf_hi(a0.y); g0[4] = bf_lo(a0.z); g0[5] = bf_hi(a0.z); g0[6] = bf_lo(a0.w); g0[7] = bf_hi(a0.w);
            v0[0] = bf_lo(b0.x); v0[1] = bf_hi(b0.x); v0[2] = bf_lo(b0.y); v0[3] = bf_hi(b0.y); v0[4] = bf_lo(b0.z); v0[5] = bf_hi(b0.z); v0[6] = bf_lo(b0.w); v0[7] = bf_hi(b0.w);
            float res[8];
#pragma unroll
            for (int e = 0; e < 8; e += 2) {
                f32x2 cg, cv;
                cg.x = bg[e] + wg[0][e] * g2[e] + wg[1][e] * g1[e] + wg[2][e] * g0[e]; cg.y = bg[e + 1] + wg[0][e + 1] * g2[e + 1] + wg[1][e + 1] * g1[e + 1] + wg[2][e + 1] * g0[e + 1];
                cv.x = bv[e] + wv[0][e] * v2[e] + wv[1][e] * v1[e] + wv[2][e] * v0[e]; cv.y = bv[e + 1] + wv[0][e + 1] * v2[e + 1] + wv[1][e + 1] * v1[e + 1] + wv[2][e + 1] * v0[e + 1];
                const f32x2 ge = pg8::gelu_pk(cg);
                res[e] = ge.x * cv.x; res[e + 1] = ge.y * cv.y;
            }
            v4u w; w.x = pk2(res[0], res[1]); w.y = pk2(res[2], res[3]); w.z = pk2(res[4], res[5]); w.w = pk2(res[6], res[7]);
            *(GAS v4u*)(act + m * DFF + j0) = w;
#pragma unroll
            for (int e = 0; e < 8; ++e) { g2[e] = g1[e]; g1[e] = g0[e]; v2[e] = v1[e]; v1[e] = v0[e]; }
        }
    }
}

constexpr int N_PHASES = 13;
struct Args { const float* in[31]; float* out; unsigned char* ws; int ph_lo, ph_hi; };
__global__ void __launch_bounds__(NWAVES * 64, 2) mk_fwd(Args args) {
    extern __shared__ __attribute__((aligned(16))) unsigned char lds[];
    Frame F;
    F.lds = (LAS unsigned char*)lds;
    F.MISC = (volatile LAS unsigned*)(F.lds + MISC_OFF);
    F.wave = __builtin_amdgcn_readfirstlane((int)threadIdx.x >> 6);
    F.G = gridDim.x; { const int bx = blockIdx.x; F.vcu = (F.G % 8 == 0) ? (bx % 8) * (F.G / 8) + bx / 8 : bx; }
    F.out = args.out; F.ws = args.ws;
    F.ctl = (gu32*)(args.ws + WS_CTL);
    for (int u = ((int)threadIdx.x); u < (LDS_BYTES - LDSCTL_OFF) / 4; u += NWAVES * 64) ((LAS unsigned*)(F.lds + LDSCTL_OFF))[u] = 0u;
    __syncthreads();
    const int lo = args.ph_lo, hi = args.ph_hi;
    XcdBarrier bar; bar.bar = (unsigned*)(F.ctl + CW_BAR); bar.x = 0; bar.st = nullptr;
    if (hi - lo > 1) bar = xcd_barrier_post((unsigned*)(F.ctl + CW_BAR), F.MISC + 8);
#ifndef PH_MASK
#define PH_MASK 0xFFFFu
#endif
#define IN(k) (((PH_MASK >> (k)) & 1u) && lo <= (k) && (k) < hi)
#define SEAM(k) do { if (IN(k) && IN((k) + 1)) xcd_barrier(bar); } while (0)
    typedef pg8::StaticOrder SO;
    const int bx = (int)blockIdx.x;
    if (IN(0)) { REP(0) phase_p0(F); SEAM(0); }
    if (IN(1)) {
        pg8::Gemm g{(const bf16*)(F.ws + WS_H0B), (const bf16*)(F.ws + WS_BT1), NTOK, N1, DM, DM, DM}; SO S; S.init(NTOK, N1, F.G, bx);
        EpiIn E{(bf16*)(F.ws + WS_MIX), (bf16*)(F.ws + WS_KB), (bf16*)(F.ws + WS_VB), (bf16*)(F.ws + WS_PRW), (const float*)(F.ws + WS_ROPE), F.out};
        REP(1) pg8::gemm_phase<EpiIn, SO, true, true>(F.lds, g, S, E);
        SEAM(1);
    }
    if (IN(2)) { REP(2) phase_prep_a(F); SEAM(2); }
    if (IN(3)) REP(3) {
        const bf16* al = (const bf16*)(F.ws + WS_ALORA);
        { pg8::Gemm g{al, (const bf16*)(F.ws + WS_BTD), NTOK, 1024, 128, 512, 128}; SO S; S.init(NTOK, 1024, F.G, bx, 128);
          EpiDecay E{(float*)(F.ws + WS_REC), inptr(12)}; pg8::gemm_phase<EpiDecay, SO, true, true>(F.lds, g, S, E); }
        { pg8::Gemm g{al + 128, (const bf16*)(F.ws + WS_BTA), NTOK, 1024, 128, 512, 128}; SO S; S.init(NTOK, 1024, F.G, (bx + 132) % F.G, 128);
          EpiVec<0> E{(bf16*)(F.ws + WS_ASIG), inptr(14)}; pg8::gemm_phase<EpiVec<0>, SO, true, true>(F.lds, g, S, E); }
        { pg8::Gemm g{al + 256, (const bf16*)(F.ws + WS_BTG), NTOK, 1024, 256, 512, 256}; SO S; S.init(NTOK, 1024, F.G, (bx + 8) % F.G, 256);
          EpiVec<1> E{(bf16*)(F.ws + WS_G), nullptr}; pg8::gemm_phase<EpiVec<1>, SO, true, true>(F.lds, g, S, E); }
    }
    SEAM(3);
    if (IN(4)) { REP(4) phase_prep_b(F); SEAM(4); }
    if (IN(5)) { phase_scan(F); SEAM(5); }
    if (IN(6)) { REP(6) phase_post(F); SEAM(6); }
    if (IN(7)) {
        pg8::Gemm g{(const bf16*)(F.ws + WS_MIX), (const bf16*)(F.ws + WS_BT2), NTOK, DM, DM, DM, DM}; { SO S; S.init(NPROMPT, DM, F.G, bx, DM); EpiRes E{F.out + O_Y}; pg8::gemm_phase<EpiRes, SO, true, true>(F.lds, g, S, E); }
        { pg8::SubOrder S; S.init(32, DM, DM, 8, F.G, bx); EpiSlab E{(float*)(F.ws + WS_SLAB)}; pg8::gemm_phase<EpiSlab, pg8::SubOrder, true, true>(F.lds, g, S, E); }
        SEAM(7);
    }
    if (IN(8)) { phase_ln<true>(F, inptr(23), inptr(24), (bf16*)(F.ws + WS_H1B), 8); SEAM(8); }
    if (IN(9)) {
        pg8::Gemm g{(const bf16*)(F.ws + WS_H1B), (const bf16*)(F.ws + WS_BT3), NTOK, NUP, DM, DM, DM}; SO S; S.init(NTOK, NUP, F.G, bx);
        EpiUp E{(bf16*)(F.ws + WS_UP), F.out}; REP(9) pg8::gemm_phase<EpiUp, SO, true, true>(F.lds, g, S, E);
        SEAM(9);
    }
    if (IN(10)) { REP(10) phase_conv(F); SEAM(10); }
    if (IN(11)) {
        pg8::Gemm g{(const bf16*)(F.ws + WS_ACT), (const bf16*)(F.ws + WS_BT4), NTOK, DM, DFF, DFF, DFF}; { SO S; S.init(NPROMPT, DM, F.G, bx, DFF); EpiRes E{F.out + O_Y}; pg8::gemm_phase<EpiRes, SO, true, true>(F.lds, g, S, E); }
        { pg8::SubOrder S; S.init(32, DM, DFF, 11, F.G, bx); EpiSlab E{(float*)(F.ws + WS_SLAB)}; pg8::gemm_phase<EpiSlab, pg8::SubOrder, true, true>(F.lds, g, S, E); }
        SEAM(11);
    }
    if (IN(12)) { phase_ln<false>(F, inptr(29), inptr(30), nullptr, 11); }
#undef IN
#undef SEAM
}

extern "C" void kernel_launch(void* const* d_in, const int* in_sizes, int n_in, void* d_out, int out_size, void* d_ws, size_t ws_size, hipStream_t stream) {
    static int grid = 0;
    if (grid == 0) {
        if (n_in != 31 || ws_size < WS_END) { fprintf(stderr, "kernel_launch: unexpected inputs (n_in %d, ws %zu)\n", n_in, ws_size); grid = -1; return; }
        int dev = 0, cus = 0, per_cu = 0;
        if (hipGetDevice(&dev) != hipSuccess || hipDeviceGetAttribute(&cus, hipDeviceAttributeMultiprocessorCount, dev) != hipSuccess) { grid = -1; return; }
        if (hipFuncSetAttribute((const void*)mk_fwd, hipFuncAttributeMaxDynamicSharedMemorySize, LDS_BYTES) != hipSuccess) { fprintf(stderr, "kernel_launch: hipFuncSetAttribute failed\n"); grid = -1; return; }
        if (hipOccupancyMaxActiveBlocksPerMultiprocessor(&per_cu, (const void*)mk_fwd, NWAVES * 64, LDS_BYTES) != hipSuccess || per_cu < 1) { fprintf(stderr, "kernel_launch: occupancy query says %d\n", per_cu); per_cu = 1; }
        (void)hipGetLastError();
        grid = cus;
    }
    if (grid < 0) return;
    (void)hipMemsetAsync((char*)d_ws + WS_CTL, 0, CTL_ZERO_BYTES, stream);
    Args a{};
    for (int i = 0; i < 31; ++i) a.in[i] = (const float*)d_in[i];
    a.out = (float*)d_out; a.ws = (unsigned char*)d_ws;
#if MK_PER_PHASE
    for (int p = 0; p < N_PHASES; ++p) { a.ph_lo = p; a.ph_hi = p + 1; hipLaunchKernelGGL(mk_fwd, dim3(grid), dim3(NWAVES * 64), LDS_BYTES, stream, a); }
#else
    a.ph_lo = 0; a.ph_hi = N_PHASES;
    hipLaunchKernelGGL(mk_fwd, dim3(grid), dim3(NWAVES * 64), LDS_BYTES, stream, a);
#endif
}
```
